# Optimizing an MI355X kernel written in HIP

```python
import math
import jax, jax.numpy as jnp
from jax import lax
import numpy as np

D_MODEL = 1024
BATCH = 16
SEQ = 2048
DEPTH = 1

CHUNK = 64
SB_BLOCK = 128
EPS = 1e-6
DN_HEADS = 4
DN_DK = 128
DN_DV = 128
DN_CONV = 4
SB_HEADS = 8
SB_DH = 64
DN_WIDTH = DN_HEADS * DN_DV
SB_WIDTH = SB_HEADS * SB_DH
N_BRANCH = 2
A_QKV1 = 2 * DN_HEADS * DN_DK + DN_WIDTH
A_Z1 = A_QKV1 + DN_WIDTH
A_B1 = A_Z1 + DN_HEADS
A_A1 = A_B1 + DN_HEADS
B_QKV1 = A_A1 + 3 * SB_WIDTH
B_Z1 = B_QKV1 + SB_WIDTH
G1 = B_Z1 + N_BRANCH * D_MODEL
PROJ_WIDTH = G1

kernel_name = 'hybrid_deltanet_stickbreaking_gated_merge'


def _rms(x, gain):
    xf = x.astype(jnp.float32)
    return xf * lax.rsqrt(jnp.mean(xf * xf, axis=-1, keepdims=True) + EPS) * gain.astype(jnp.float32)


def _l2n(x):
    return x * lax.rsqrt(jnp.sum(x * x, axis=-1, keepdims=True) + EPS)


def _causal_dwconv(u, w):
    k_len, c = w.shape
    return lax.conv_general_dilated(u, w[:, None, :].astype(u.dtype), window_strides=(1,),
                                    padding=[(k_len - 1, 0)],
                                    dimension_numbers=('NWC', 'WIO', 'NWC'),
                                    feature_group_count=c)


def _gated_delta_rule(q, k, v, g, beta):
    b, s, h, dk = q.shape
    dv = v.shape[-1]
    n = s // CHUNK

    def blocks(t):
        return jnp.moveaxis(t.reshape(b, n, CHUNK, h, -1), 3, 1)

    q = blocks(q) * dk ** -0.5
    k = blocks(k)
    v = blocks(v)
    g = jnp.moveaxis(g.reshape(b, n, CHUNK, h), 3, 1)
    beta = jnp.moveaxis(beta.reshape(b, n, CHUNK, h), 3, 1)
    gc = jnp.cumsum(g, axis=-1)
    causal = jnp.tril(jnp.ones((CHUNK, CHUNK), dtype=bool))
    strict = jnp.tril(jnp.ones((CHUNK, CHUNK), dtype=bool), -1)
    decay = jnp.exp(jnp.where(causal, gc[..., :, None] - gc[..., None, :], -jnp.inf))
    kk = jnp.einsum('bhnid,bhnjd->bhnij', k, k)
    m = jnp.where(strict, beta[..., :, None] * kk * decay, 0.0)
    eye = jnp.eye(CHUNK, dtype=m.dtype)
    rhs = jnp.concatenate([beta[..., None] * v,
                           beta[..., None] * k * jnp.exp(gc)[..., None]], axis=-1)
    sol = lax.linalg.triangular_solve(eye + m, rhs, left_side=True, lower=True, unit_diagonal=True)
    u, w = sol[..., :dv], sol[..., dv:]
    qk = jnp.where(causal, jnp.einsum('bhnid,bhnjd->bhnij', q, k) * decay, 0.0)
    q_dec = q * jnp.exp(gc)[..., None]
    k_dec = k * jnp.exp(gc[..., -1:] - gc)[..., None]
    g_end = jnp.exp(gc[..., -1])

    def step(state, inp):
        qk_c, qd_c, kd_c, u_c, w_c, ge_c = inp
        v_new = u_c - jnp.einsum('bhck,bhkv->bhcv', w_c, state)
        o = (jnp.einsum('bhck,bhkv->bhcv', qd_c, state)
             + jnp.einsum('bhij,bhjv->bhiv', qk_c, v_new))
        state = state * ge_c[..., None, None] + jnp.einsum('bhck,bhcv->bhkv', kd_c, v_new)
        return state, o

    xs = tuple(jnp.moveaxis(t, 2, 0) for t in (qk, q_dec, k_dec, u, w, g_end))
    state0 = jnp.zeros((b, h, dk, dv), q.dtype)
    _, o = lax.scan(step, state0, xs)
    return jnp.transpose(o, (1, 0, 3, 2, 4)).reshape(b, s, h, dv)


def _stick_breaking(q, k, v):
    _, _, s, d = q.shape
    scale = d ** -0.5
    outs = []
    for blk in range(s // SB_BLOCK):
        q0 = blk * SB_BLOCK
        end = q0 + SB_BLOCK
        z = jnp.einsum('bhqd,bhkd->bhqk', q[:, :, q0:end], k[:, :, :end]) * scale
        qi = q0 + jnp.arange(SB_BLOCK)[:, None]
        kj = jnp.arange(end)[None, :]
        mask = kj < qi
        log_keep = jnp.where(mask, jax.nn.log_sigmoid(-z), 0.0)
        rest = lax.cumsum(log_keep, axis=3, reverse=True) - log_keep
        a = jnp.where(mask, jnp.exp(jax.nn.log_sigmoid(z) + rest), 0.0)
        outs.append(jnp.einsum('bhqk,bhkd->bhqd', a, v[:, :, :end]))
    return jnp.concatenate(outs, axis=2)


def _layer(x, norm_gain, w_in, b_gate, conv_w, a_log, dt_bias, dn_out_gain,
           sb_q_gain, sb_k_gain, w_up_a, w_up_b, w_out):
    f32 = jnp.float32
    b, s, _ = x.shape
    xn = _rms(x, norm_gain).astype(x.dtype)
    proj = jnp.einsum('bsd,dp->bsp', xn, w_in)

    nqk = DN_HEADS * DN_DK
    qkv_a = jax.nn.silu(_causal_dwconv(proj[..., :A_QKV1], conv_w)).astype(f32)
    q_a = _l2n(qkv_a[..., :nqk].reshape(b, s, DN_HEADS, DN_DK))
    k_a = _l2n(qkv_a[..., nqk:2 * nqk].reshape(b, s, DN_HEADS, DN_DK))
    v_a = qkv_a[..., 2 * nqk:].reshape(b, s, DN_HEADS, DN_DV)
    z_a = proj[..., A_QKV1:A_Z1].astype(f32)
    beta = jax.nn.sigmoid(proj[..., A_Z1:A_B1].astype(f32))
    g = -jnp.exp(a_log.astype(f32)) * jax.nn.softplus(proj[..., A_B1:A_A1].astype(f32)
                                                       + dt_bias.astype(f32))
    o_a = _gated_delta_rule(q_a, k_a, v_a, g, beta)
    o_a = _rms(o_a, dn_out_gain).reshape(b, s, DN_WIDTH) * jax.nn.silu(z_a)
    y_a = jnp.einsum('bsc,cd->bsd', o_a.astype(x.dtype), w_up_a)

    qkv_b = proj[..., A_A1:B_QKV1].astype(f32).reshape(b, s, 3, SB_HEADS, SB_DH)
    q_b = jnp.swapaxes(_rms(qkv_b[:, :, 0], sb_q_gain), 1, 2)
    k_b = jnp.swapaxes(_rms(qkv_b[:, :, 1], sb_k_gain), 1, 2)
    v_b = jnp.swapaxes(qkv_b[:, :, 2], 1, 2)
    z_b = proj[..., B_QKV1:B_Z1].astype(f32)
    o_b = jnp.swapaxes(_stick_breaking(q_b, k_b, v_b), 1, 2).reshape(b, s, SB_WIDTH)
    o_b = o_b * jax.nn.silu(z_b)
    y_b = jnp.einsum('bsc,cd->bsd', o_b.astype(x.dtype), w_up_b)

    gates = jax.nn.sigmoid(proj[..., B_Z1:G1].astype(f32) + b_gate.astype(f32))
    merged = gates[..., :D_MODEL] * y_a.astype(f32) + gates[..., D_MODEL:] * y_b.astype(f32)
    return x + jnp.einsum('bsd,de->bse', merged.astype(x.dtype), w_out)


def setup_inputs(seed: int = 0) -> dict:
    key = jax.random.key(seed)
    ks = jax.random.split(key, 14)
    f32 = jnp.float32
    nl = DEPTH
    nrm = jax.random.normal
    x = nrm(ks[0], (BATCH, SEQ, D_MODEL), f32)
    norm_gain = 1.0 + 0.02 * nrm(ks[1], (nl, D_MODEL), f32)
    w_in = nrm(ks[2], (nl, D_MODEL, PROJ_WIDTH), f32) * D_MODEL ** -0.5
    b_gate = 0.02 * nrm(ks[3], (nl, N_BRANCH * D_MODEL), f32)
    conv_w = nrm(ks[4], (nl, DN_CONV, A_QKV1), f32) * DN_CONV ** -0.5
    a_log = jnp.log(jax.random.uniform(ks[5], (nl, DN_HEADS), f32, minval=1.0, maxval=16.0))
    dt = jnp.exp(jax.random.uniform(ks[6], (nl, DN_HEADS), f32,
                                    minval=math.log(1e-3), maxval=math.log(1e-1)))
    dt_bias = dt + jnp.log(-jnp.expm1(-dt))
    dn_out_gain = 1.0 + 0.02 * nrm(ks[7], (nl, DN_DV), f32)
    sb_q_gain = 1.0 + 0.02 * nrm(ks[8], (nl, SB_DH), f32)
    sb_k_gain = 1.0 + 0.02 * nrm(ks[9], (nl, SB_DH), f32)
    w_up_a = nrm(ks[10], (nl, DN_WIDTH, D_MODEL), f32) * DN_WIDTH ** -0.5
    w_up_b = nrm(ks[11], (nl, SB_WIDTH, D_MODEL), f32) * SB_WIDTH ** -0.5
    w_out = nrm(ks[12], (nl, D_MODEL, D_MODEL), f32) * D_MODEL ** -0.5
    return {'x': x, 'norm_gain': norm_gain, 'w_in': w_in, 'b_gate': b_gate, 'conv_w': conv_w,
            'a_log': a_log, 'dt_bias': dt_bias, 'dn_out_gain': dn_out_gain,
            'sb_q_gain': sb_q_gain, 'sb_k_gain': sb_k_gain, 'w_up_a': w_up_a,
            'w_up_b': w_up_b, 'w_out': w_out}


def reference(x, norm_gain, w_in, b_gate, conv_w, a_log, dt_bias, dn_out_gain,
              sb_q_gain, sb_k_gain, w_up_a, w_up_b, w_out):
    h = x
    for layer in range(DEPTH):
        h = _layer(h, norm_gain[layer], w_in[layer], b_gate[layer], conv_w[layer],
                   a_log[layer], dt_bias[layer], dn_out_gain[layer], sb_q_gain[layer],
                   sb_k_gain[layer], w_up_a[layer], w_up_b[layer], w_out[layer])
    return h
```

```cpp
#include <hip/hip_runtime.h>
#include <hip/hip_cooperative_groups.h>
#include <cstdio>
#include <cstdint>
namespace cg = cooperative_groups;

#define LAS __attribute__((address_space(3)))
typedef unsigned short bf16_t;
typedef short bf16x8 __attribute__((ext_vector_type(8)));
typedef float f32x4 __attribute__((ext_vector_type(4)));
typedef unsigned u32x4 __attribute__((ext_vector_type(4)));
typedef unsigned u32x2 __attribute__((ext_vector_type(2)));
typedef __bf16 bf16x2_t __attribute__((ext_vector_type(2)));

constexpr int M = 32768, DM = 1024, SEQ = 2048;
constexpr int N1 = 4096;
constexpr int PROJ = 6152;
constexpr float EPS = 1e-6f;
constexpr float QSCALE = 0.125f * 1.4426950408889634f;
constexpr int NWAVES = 8;
constexpr size_t MiB = (size_t)1 << 20;
constexpr size_t WS_CTL = 0, WS_W1T = 1 * MiB, WS_WGT = 9 * MiB, WS_WUPT = 13 * MiB, WS_WOT = 15 * MiB, WS_BG = 17 * MiB, WS_XN = 18 * MiB, WS_P1 = 82 * MiB,
                 WS_QKVA = 338 * MiB, WS_ORAW = 434 * MiB, WS_UF = 466 * MiB, WS_END = 498 * MiB;
constexpr size_t WS_GE = 4096;
constexpr size_t WS_BAR = 65536;
constexpr size_t WS_MG = WS_QKVA;
constexpr size_t WS_GSC = WS_ORAW;
constexpr size_t OUT_REC = 0, OUT_GY = 64 * MiB;
constexpr int REC_BYTES = 57344;
constexpr int LDS_BYTES = 147456 + 256;

typedef float f32x2_t __attribute__((ext_vector_type(2)));
__device__ __forceinline__ unsigned cvt_pk_bf16(float lo, float hi) { unsigned r; asm volatile("s_nop 1\n\tv_cvt_pk_bf16_f32 %0, %1, %2\n\ts_nop 1" : "=v"(r) : "v"(lo), "v"(hi)); return r; }
__device__ __forceinline__ unsigned cvt_pk_safe(float lo, float hi) { unsigned r; asm volatile("s_nop 7\n\ts_nop 7\n\ts_nop 3\n\tv_cvt_pk_bf16_f32 %0, %1, %2\n\ts_nop 1" : "=v"(r) : "v"(lo), "v"(hi)); return r; }
__device__ __forceinline__ float bflo(unsigned w) { return __uint_as_float(w << 16); }
__device__ __forceinline__ float bfhi(unsigned w) { return __uint_as_float(w & 0xffff0000u); }
__device__ __forceinline__ float sigmoidf_(float v) { return __builtin_amdgcn_rcpf(1.0f + __expf(-v)); }
__device__ __forceinline__ float wave_sum(float v) {
#pragma unroll
    for (int o = 1; o < 64; o <<= 1) v += __shfl_xor(v, o);
    return v;
}
#define DPP_ADD(v, CTRL) v += __builtin_bit_cast(float, __builtin_amdgcn_update_dpp(0, __builtin_bit_cast(int, v), CTRL, 0xF, 0xF, true))
__device__ __forceinline__ float red16(float v) {
    DPP_ADD(v, 0xB1); DPP_ADD(v, 0x4E); DPP_ADD(v, 0x141); DPP_ADD(v, 0x140);
    return v;
}

namespace pg8 {
constexpr int BM = 256, BK = 64, HALF = 128, HTB = HALF * BK * 2, NXCD = 8, WGM = 8;
constexpr int PITCH = 2048;
__device__ __forceinline__ int lds_byte(int r, int c) { const int st = (r >> 4) * 2 + (c >> 5), rr = r & 15, cc = c & 31, ob = rr * 64 + cc * 2; return st * 1024 + (ob ^ (((ob >> 9) & 1) << 5)); }
__device__ __forceinline__ void stage_rc(int b, int& R, int& C) { const int st = b / 1024, sb = b % 1024, swz = sb ^ (((sb >> 9) & 1) << 5); R = (st >> 1) * 16 + swz / 64; C = (st & 1) * 32 + (swz % 64) / 2; }
__device__ __forceinline__ int perm32(int rho) { const int n = rho >> 4, i = rho & 15; return 8 * (i >> 2) + 4 * n + (i & 3); }

struct Unit { const char* A; const char* B; int nt, pm, pn, sub, ap; };

__device__ __forceinline__ void tile_of(int L, int nM, int nN, int& pm, int& pn) {
    const int nwg = nM * nN; int wgid = L;
    { const int q = nwg / NXCD, r = nwg % NXCD, xcd = wgid % NXCD, off = wgid / NXCD; wgid = (xcd < r ? xcd * (q + 1) : r * (q + 1) + (xcd - r) * q) + off; }
    const int nig = WGM * nN, gid = wgid / nig, fm = gid * WGM, gsz = (nM - fm) < WGM ? (nM - fm) : WGM;
    pm = fm + ((wgid % nig) % gsz); pn = (wgid % nig) / gsz;
}
struct SchedPlain {
    const char* A; const char* B; int nt, nM, nN, G, c;
    __device__ __forceinline__ bool next(int i, Unit& u) const {
        const long L = (long)i * G + c; if (L >= (long)nM * nN) return false;
        tile_of((int)L, nM, nN, u.pm, u.pn);
        u.A = A + (size_t)u.pm * BM * PITCH; u.B = B + (size_t)u.pn * BM * PITCH; u.nt = nt; u.sub = 0; u.ap = 0; return true;
    }
};
struct SchedP5 {
    const char* XN; const char* WG; const char* P1; const char* WUP; int G, c;
    __device__ __forceinline__ bool next(int i, Unit& u) const {
        const int ti = i >> 2, sub = i & 3; const long L = (long)ti * G + c; if (L >= 128 * 4) return false;
        tile_of((int)L, 128, 4, u.pm, u.pn); u.sub = sub;
        if (sub == 0)      { u.A = XN + (size_t)u.pm * BM * PITCH;            u.B = WG + (size_t)(u.pn * BM) * PITCH;         u.nt = 16; u.ap = 0; }
        else if (sub == 1) { u.A = P1 + (size_t)u.pm * BM * 8192 + 1536 * 2; u.B = WUP + (size_t)(u.pn * BM) * PITCH;        u.nt = 8;  u.ap = 1; }
        else if (sub == 2) { u.A = XN + (size_t)u.pm * BM * PITCH;            u.B = WG + (size_t)(1024 + u.pn * BM) * PITCH;  u.nt = 16; u.ap = 0; }
        else               { u.A = P1 + (size_t)u.pm * BM * 8192 + 2048 * 2; u.B = WUP + (size_t)(u.pn * BM) * PITCH + 1024; u.nt = 8;  u.ap = 1; }
        return true;
    }
};

template <class Epi, class Sched>
__device__ __forceinline__ void gemm_phase(LAS unsigned char* lds, const Sched& S, const Epi& E) {
    int tid = threadIdx.x; asm volatile("" : "+v"(tid));
    const int wid = __builtin_amdgcn_readfirstlane(tid >> 6), lane = tid & 63, wr = wid >> 2, wc = wid & 3, fr = lane & 15, fq = lane >> 4;
    unsigned vRC, voffB;
    { int R, C; stage_rc(tid * 16, R, C); const int Rb = (R & ~31) + perm32(R & 31); vRC = (unsigned)(R * PITCH + C * 2); voffB = (unsigned)(Rb * PITCH + C * 2); }
#define PG8_VA(ap) ((ap) ? (((vRC >> 11) << 13) + (vRC & 2047u)) : vRC)
    const size_t kstep = (size_t)(BK * 2);
    const size_t hstep = (size_t)HALF * PITCH;
    const unsigned ldsw = (unsigned)wid * 1024u;
    const int aoff = lds_byte(wr * 64 + fr, fq * 8), boff = lds_byte(wc * 32 + fr, fq * 8);
#define PG8_SA(b, h) (((b) * 2 + (h)) * HTB)
#define PG8_SB(b, h) ((4 + (b) * 2 + (h)) * HTB)
#define PG8_STAGE(bufoff, gbase, voff, d64) do { _Pragma("unroll") for (int _i = 0; _i < 2; ++_i) \
        __builtin_amdgcn_global_load_lds((const unsigned*)((const char*)(gbase) + (size_t)_i * (d64) + (voff)), (LAS unsigned*)(lds + (bufoff) + ldsw + _i * 8192), 16, 0, 0); } while (0)
#define PG8_STAGEB(bufoff, gbase) PG8_STAGE(bufoff, gbase, voffB, (size_t)64 * PITCH)
#define PG8_LDA(dst, b, h) do { _Pragma("unroll") for (int m = 0; m < 4; ++m) _Pragma("unroll") for (int k = 0; k < 2; ++k) dst[m][k] = *(const LAS bf16x8*)(lds + PG8_SA(b, h) + aoff + m * 2048 + k * 1024); } while (0)
#define PG8_LDB(dst, b, h) do { _Pragma("unroll") for (int n = 0; n < 2; ++n) _Pragma("unroll") for (int k = 0; k < 2; ++k) dst[n][k] = *(const LAS bf16x8*)(lds + PG8_SB(b, h) + boff + n * 2048 + k * 1024); } while (0)
#define PG8_MMA(ai, bj, At, Bt) do { __builtin_amdgcn_s_setprio(1); _Pragma("unroll") for (int m = 0; m < 4; ++m) _Pragma("unroll") for (int n = 0; n < 2; ++n) _Pragma("unroll") for (int k = 0; k < 2; ++k) \
        acc[ai][bj][m][n] = __builtin_amdgcn_mfma_f32_16x16x32_bf16(Bt[n][k], At[m][k], acc[ai][bj][m][n], 0, 0, 0); __builtin_amdgcn_s_setprio(0); } while (0)
#define PG8_WAIT_V(n) asm volatile("s_waitcnt vmcnt(" #n ")" ::: "memory")
#define PG8_WAIT_L(n) asm volatile("s_waitcnt lgkmcnt(" #n ")" ::: "memory")
#define PG8_BAR __builtin_amdgcn_s_barrier()
#define PG8_SCHED __builtin_amdgcn_sched_barrier(0)
    Unit cur, nxt; int ui = 0;
    if (!S.next(0, cur)) return;
    f32x4 acc[2][2][4][2];
#pragma unroll
    for (int a = 0; a < 2; ++a)
#pragma unroll
        for (int b = 0; b < 2; ++b)
#pragma unroll
            for (int m = 0; m < 4; ++m)
#pragma unroll
                for (int n = 0; n < 2; ++n) acc[a][b][m][n] = (f32x4){0.f, 0.f, 0.f, 0.f};
    bf16x8 At[4][2], B0[2][2], B1[2][2];
    const char* cA = cur.A; const char* cB = cur.B;
    unsigned voffA = PG8_VA(cur.ap);
    size_t hA = cur.ap ? (size_t)HALF * 8192 : hstep;
    PG8_STAGEB(PG8_SB(0, 0), cB); PG8_STAGEB(PG8_SB(0, 1), cB + hstep); PG8_STAGE(PG8_SA(0, 0), cA, voffA, hA >> 1); PG8_STAGE(PG8_SA(0, 1), cA + hA, voffA, hA >> 1);
    if (wr == 1) PG8_BAR;
    PG8_WAIT_V(2); PG8_BAR;
    PG8_STAGEB(PG8_SB(1, 0), cB + kstep); PG8_STAGE(PG8_SA(1, 0), cA + kstep, voffA, hA >> 1); PG8_STAGEB(PG8_SB(1, 1), cB + hstep + kstep);
    PG8_WAIT_V(6); PG8_BAR;
    for (;;) {
        const bool has_next = S.next(ui + 1, nxt);
        const char* nA = has_next ? nxt.A : cA; const char* nB = has_next ? nxt.B : cB;
        const int nap = has_next ? nxt.ap : cur.ap;
        const unsigned voffN = PG8_VA(nap);
        const size_t hN = nap ? (size_t)HALF * 8192 : hstep;
        const int nt = cur.nt;
        for (int t = 0; t < nt; t += 2) {
            const bool last = (t == nt - 2);
            const char* a1 = cA + (size_t)(t + 1) * kstep;
            const char* a2 = last ? nA : cA + (size_t)(t + 2) * kstep; const char* b2 = last ? nB : cB + (size_t)(t + 2) * kstep;
            const char* a3 = a2 + kstep; const char* b3 = b2 + kstep;
            const unsigned voff2 = last ? voffN : voffA;
            const size_t h2 = last ? hN : hA;
            PG8_LDB(B0, 0, 0); PG8_LDB(B1, 0, 1); PG8_SCHED; PG8_LDA(At, 0, 0); PG8_STAGE(PG8_SA(1, 1), a1 + hA, voffA, hA >> 1);
            PG8_WAIT_V(8); PG8_WAIT_L(0); PG8_BAR; PG8_MMA(0, 0, At, B0); PG8_MMA(0, 1, At, B1); PG8_BAR; PG8_SCHED;
            PG8_LDA(At, 0, 1); PG8_STAGEB(PG8_SB(0, 0), b2); PG8_STAGEB(PG8_SB(0, 1), b2 + hstep); PG8_STAGE(PG8_SA(0, 0), a2, voff2, h2 >> 1);
            PG8_WAIT_V(8); PG8_WAIT_L(0); PG8_BAR; PG8_MMA(1, 0, At, B0); PG8_MMA(1, 1, At, B1); PG8_BAR; PG8_SCHED;
            PG8_LDB(B0, 1, 0); PG8_LDB(B1, 1, 1); PG8_SCHED; PG8_LDA(At, 1, 0); PG8_STAGE(PG8_SA(0, 1), a2 + h2, voff2, h2 >> 1);
            PG8_WAIT_V(8); PG8_WAIT_L(0); PG8_BAR; PG8_MMA(0, 0, At, B0); PG8_MMA(0, 1, At, B1); PG8_BAR; PG8_SCHED;
            PG8_LDA(At, 1, 1); PG8_STAGEB(PG8_SB(1, 0), b3); PG8_STAGEB(PG8_SB(1, 1), b3 + hstep); PG8_STAGE(PG8_SA(1, 0), a3, voff2, h2 >> 1);
            PG8_WAIT_V(8); PG8_WAIT_L(0); PG8_BAR; PG8_MMA(1, 0, At, B0); PG8_MMA(1, 1, At, B1); PG8_BAR; PG8_SCHED;
        }
        if (wr == 0) PG8_BAR;
        E(acc, cur, wr, wc, fr, fq);
        if (!has_next) break;
#pragma unroll
        for (int a = 0; a < 2; ++a)
#pragma unroll
            for (int b = 0; b < 2; ++b)
#pragma unroll
                for (int m = 0; m < 4; ++m)
#pragma unroll
                    for (int n = 0; n < 2; ++n) acc[a][b][m][n] = (f32x4){0.f, 0.f, 0.f, 0.f};
        cur = nxt; cA = nA; cB = nB; ++ui; voffA = voffN; hA = hN;
        if (wr == 1) PG8_BAR;
    }
    PG8_WAIT_V(0);
    PG8_BAR;
#undef PG8_SA
#undef PG8_SB
#undef PG8_STAGE
#undef PG8_STAGEB
#undef PG8_VA
#undef PG8_LDA
#undef PG8_LDB
#undef PG8_MMA
#undef PG8_WAIT_V
#undef PG8_WAIT_L
#undef PG8_BAR
#undef PG8_SCHED
}

struct Epi1 {
    bf16_t* P1; const float* qg; const float* kg;
    __device__ __forceinline__ void operator()(const f32x4 (&acc)[2][2][4][2], const Unit& u, int wr, int wc, int fr, int fq) const {
        const int pn = u.pn;
        const int kind = (pn < 6) ? 0 : (pn < 8) ? 1 : (pn < 10) ? 2 : (pn < 12) ? 3 : (pn < 14) ? 4 : 1;
        const int col0 = pn * BM + wc * 64 + 8 * fq;
        const size_t row0 = (size_t)u.pm * BM + wr * 64 + fr;
        f32x4 gn[2][2];
#pragma unroll
        for (int bj = 0; bj < 2; ++bj)
#pragma unroll
            for (int n = 0; n < 2; ++n) gn[bj][n] = (f32x4){1.f, 1.f, 1.f, 1.f};
        if (kind >= 2) { const float* g = (kind == 2) ? qg : kg; const float sc = (kind == 2) ? QSCALE : 1.0f;
#pragma unroll
            for (int bj = 0; bj < 2; ++bj)
#pragma unroll
                for (int n = 0; n < 2; ++n) gn[bj][n] = *(const f32x4*)(g + 32 * bj + 8 * fq + 4 * n) * sc; }
        if (kind == 4) {
            const int hh = 4 * (pn - 12) + wc; const int tok0 = u.pm * BM + wr * 64 + fr; const int bb = tok0 >> 11;
            bf16_t* vb = P1 + (size_t)bb * SEQ * N1 + 3072 + 64 * hh;
#pragma unroll
            for (int ai = 0; ai < 2; ++ai)
#pragma unroll
                for (int m = 0; m < 4; ++m) { const int sq = (tok0 + ai * HALF + m * 16) & (SEQ - 1); const int cs = (sq & 48) | ((sq & 4) << 1) | ((sq & 8) >> 1) | (sq & 3);
                    unsigned off = (unsigned)((sq >> 6) * N1 + cs + (8 * fq) * 32 * N1); asm volatile("" : "+v"(off));
#pragma unroll
                    for (int bj = 0; bj < 2; ++bj)
#pragma unroll
                        for (int n = 0; n < 2; ++n) { const f32x4 x = acc[ai][bj][m][n]; const unsigned w0 = cvt_pk_bf16(x[0], x[1]), w1 = cvt_pk_bf16(x[2], x[3]); bf16_t* bp = vb + off + (unsigned)((32 * bj + 4 * n) * 32 * N1);
                            bp[0 * 32 * N1] = (bf16_t)(w0 & 0xffffu); bp[1 * 32 * N1] = (bf16_t)(w0 >> 16); bp[2 * 32 * N1] = (bf16_t)(w1 & 0xffffu); bp[3 * 32 * N1] = (bf16_t)(w1 >> 16); }
                    asm volatile("" ::: "memory"); }
            return;
        }
#pragma unroll
        for (int ai = 0; ai < 2; ++ai)
#pragma unroll
            for (int m = 0; m < 4; ++m) {
                bf16_t* rowp = P1 + (row0 + ai * HALF + m * 16) * N1 + col0;
                float rs = 1.f;
                if (kind >= 2) { float ss = 0.f;
#pragma unroll
                    for (int bj = 0; bj < 2; ++bj)
#pragma unroll
                        for (int n = 0; n < 2; ++n) { const f32x4 x = acc[ai][bj][m][n]; ss += (x[0] * x[0] + x[1] * x[1]) + (x[2] * x[2] + x[3] * x[3]); }
                    ss += __shfl_xor(ss, 16); ss += __shfl_xor(ss, 32);
                    rs = __builtin_amdgcn_rsqf(ss * (1.0f / 64.0f) + EPS); }
#pragma unroll
                for (int bj = 0; bj < 2; ++bj) { f32x4 v0 = acc[ai][bj][m][0], v1 = acc[ai][bj][m][1];
                    if (kind == 1) {
#pragma unroll
                        for (int j = 0; j < 4; ++j) { v0[j] = v0[j] * sigmoidf_(v0[j]); v1[j] = v1[j] * sigmoidf_(v1[j]); } }
                    else if (kind >= 2) { v0 = v0 * rs * gn[bj][0]; v1 = v1 * rs * gn[bj][1]; }
                    u32x4 w; w.x = cvt_pk_bf16(v0[0], v0[1]); w.y = cvt_pk_bf16(v0[2], v0[3]); w.z = cvt_pk_bf16(v1[0], v1[1]); w.w = cvt_pk_bf16(v1[2], v1[3]);
                    *(u32x4*)(rowp + 32 * bj) = w; }
                asm volatile("" ::: "memory");
            }
    }
};
struct Epi5 {
    const float* bgate; bf16_t* gsc; bf16_t* gy; bf16_t* MG;
    __device__ __forceinline__ void operator()(const f32x4 (&acc)[2][2][4][2], const Unit& u, int wr, int wc, int fr, int fq) const {
        const int sub = u.sub;
        const int lc0 = wc * 32 + 8 * fq, lr0 = wr * 64 + fr;
        int toff = lr0 * 256 + lc0; asm volatile("" : "+v"(toff));
        if (sub == 0 || sub == 2) {
            const float* bp = bgate + (sub == 2 ? 1024 : 0) + u.pn * BM + lc0;
            f32x4 bb[2][2];
#pragma unroll
            for (int bj = 0; bj < 2; ++bj) { bb[bj][0] = *(const f32x4*)(bp + bj * HALF); bb[bj][1] = *(const f32x4*)(bp + bj * HALF + 4); }
#pragma unroll
            for (int ai = 0; ai < 2; ++ai)
#pragma unroll
                for (int m = 0; m < 4; ++m) {
#pragma unroll
                    for (int bj = 0; bj < 2; ++bj) { const f32x4 a0 = acc[ai][bj][m][0] + bb[bj][0], a1 = acc[ai][bj][m][1] + bb[bj][1];
                        u32x4 w; w.x = cvt_pk_bf16(sigmoidf_(a0[0]), sigmoidf_(a0[1])); w.y = cvt_pk_bf16(sigmoidf_(a0[2]), sigmoidf_(a0[3]));
                        w.z = cvt_pk_bf16(sigmoidf_(a1[0]), sigmoidf_(a1[1])); w.w = cvt_pk_bf16(sigmoidf_(a1[2]), sigmoidf_(a1[3]));
                        *(u32x4*)(gsc + toff + (ai * HALF + m * 16) * 256 + bj * HALF) = w; }
                    asm volatile("" ::: "memory"); }
        } else if (sub == 1) {
#pragma unroll
            for (int ai = 0; ai < 2; ++ai)
#pragma unroll
                for (int m = 0; m < 4; ++m) {
#pragma unroll
                    for (int bj = 0; bj < 2; ++bj) { const int o = toff + (ai * HALF + m * 16) * 256 + bj * HALF; const f32x4 a0 = acc[ai][bj][m][0], a1 = acc[ai][bj][m][1];
                        const u32x4 g = *(const u32x4*)(gsc + o); u32x4 w;
                        w.x = cvt_pk_bf16(bflo(g.x) * a0[0], bfhi(g.x) * a0[1]); w.y = cvt_pk_bf16(bflo(g.y) * a0[2], bfhi(g.y) * a0[3]);
                        w.z = cvt_pk_bf16(bflo(g.z) * a1[0], bfhi(g.z) * a1[1]); w.w = cvt_pk_bf16(bflo(g.w) * a1[2], bfhi(g.w) * a1[3]);
                        *(u32x4*)(gy + o) = w; }
                    asm volatile("" ::: "memory"); }
        } else {
            bf16_t* mg = MG + ((size_t)u.pm * BM + lr0) * DM + u.pn * BM + lc0;
#pragma unroll
            for (int ai = 0; ai < 2; ++ai)
#pragma unroll
                for (int m = 0; m < 4; ++m) {
#pragma unroll
                    for (int bj = 0; bj < 2; ++bj) { const int o = toff + (ai * HALF + m * 16) * 256 + bj * HALF; const f32x4 a0 = acc[ai][bj][m][0], a1 = acc[ai][bj][m][1];
                        const u32x4 g = *(const u32x4*)(gsc + o); const u32x4 y = *(const u32x4*)(gy + o); u32x4 w;
                        w.x = cvt_pk_bf16(bflo(y.x) + bflo(g.x) * a0[0], bfhi(y.x) + bfhi(g.x) * a0[1]); w.y = cvt_pk_bf16(bflo(y.y) + bflo(g.y) * a0[2], bfhi(y.y) + bfhi(g.y) * a0[3]);
                        w.z = cvt_pk_bf16(bflo(y.z) + bflo(g.z) * a1[0], bfhi(y.z) + bfhi(g.z) * a1[1]); w.w = cvt_pk_bf16(bflo(y.w) + bflo(g.w) * a1[2], bfhi(y.w) + bfhi(g.w) * a1[3]);
                        *(u32x4*)(mg + (ai * HALF + m * 16) * DM + bj * HALF) = w; }
                    asm volatile("" ::: "memory"); }
        }
    }
};
struct Epi6 {
    const float* x; float* out;
    __device__ __forceinline__ void operator()(const f32x4 (&acc)[2][2][4][2], const Unit& u, int wr, int wc, int fr, int fq) const {
        const int lc0 = u.pn * BM + wc * 32 + 8 * fq; const size_t row0 = (size_t)u.pm * BM + wr * 64 + fr;
#pragma unroll
        for (int ai = 0; ai < 2; ++ai)
#pragma unroll
            for (int m = 0; m < 4; ++m) { const size_t off = (row0 + ai * HALF + m * 16) * DM + lc0;
#pragma unroll
                for (int bj = 0; bj < 2; ++bj) { const f32x4 x0 = *(const f32x4*)(x + off + bj * HALF), x1 = *(const f32x4*)(x + off + bj * HALF + 4);
                    *(f32x4*)(out + off + bj * HALF) = x0 + acc[ai][bj][m][0]; *(f32x4*)(out + off + bj * HALF + 4) = x1 + acc[ai][bj][m][1]; }
                asm volatile("" ::: "memory"); }
    }
};
}

#define XB_TMO      128
#define XB_XCNT(j)  (256  + 64 * (j))
#define XB_XSUB(j)  (1280 + 64 * (j))
#define XB_XGEN(j)  (2304 + 64 * (j))
#define XB_TOP      3328
#define XB_TOPGEN   3392
#define XCD_BAR_WORDS 3456
#define XB_SPIN_CAP (1u << 18)

__device__ __forceinline__ unsigned xb_ld(unsigned* p)              { return __hip_atomic_load(p, __ATOMIC_RELAXED, __HIP_MEMORY_SCOPE_AGENT); }
__device__ __forceinline__ unsigned xb_add(unsigned* p, unsigned v) { return __hip_atomic_fetch_add(p, v, __ATOMIC_RELAXED, __HIP_MEMORY_SCOPE_AGENT); }
__device__ __forceinline__ unsigned xb_xcc_id() { return (unsigned)__builtin_amdgcn_s_getreg((3 << 11) | 20) & 0xFu; }
#define XB_SPIN(cond, bar) do { unsigned _sp = 0; while (cond) { __builtin_amdgcn_s_sleep(1); \
    if ((++_sp & 255u) == 0u) { if (xb_ld(&(bar)[XB_TMO])) break; if (_sp > XB_SPIN_CAP) { atomicAdd(&(bar)[XB_TMO], 1u); break; } } } } while (0)

struct XcdBarrier {
    unsigned* bar; unsigned x;
    volatile LAS unsigned* st;
};

__device__ __forceinline__ XcdBarrier xcd_barrier_post(unsigned* bar, volatile LAS unsigned* st) {
    XcdBarrier b; b.bar = bar; b.x = xb_xcc_id(); b.st = st;
    if (threadIdx.x == 0) (void)xb_add(&bar[XB_XCNT(b.x)], 1u);
    return b;
}
__device__ __forceinline__ void xcd_barrier_complete(unsigned* bar, unsigned x, unsigned& nloc, unsigned& nx) {
    const unsigned G = gridDim.x * gridDim.y * gridDim.z;
    unsigned sum, cnt, mine, sp = 0u;
    for (;;) {
        sum = 0u; cnt = 0u; mine = 0u;
#pragma unroll
        for (unsigned j = 0; j < 16; ++j) { const unsigned c = xb_ld(&bar[XB_XCNT(j)]); sum += c; cnt += (c > 0u) ? 1u : 0u; mine = (j == x) ? c : mine; }
        if (sum == G) break;
        __builtin_amdgcn_s_sleep(1);
        if ((++sp & 255u) == 0u) { if (xb_ld(&bar[XB_TMO])) break; if (sp > XB_SPIN_CAP) { atomicAdd(&bar[XB_TMO], 1u); break; } }
    }
    nloc = mine > 0u ? mine : 1u; nx = cnt > 0u ? cnt : 1u;
}

__device__ __forceinline__ void xcd_barrier(const XcdBarrier& b) {
    asm volatile("s_waitcnt vmcnt(0)" ::: "memory");
    __syncthreads();
    if (threadIdx.x == 0) {
        unsigned* bar = b.bar;
        __builtin_amdgcn_s_waitcnt(0);
        unsigned nloc = b.st[0], nx = b.st[1];
        if (nloc == 0u) { xcd_barrier_complete(bar, b.x, nloc, nx); b.st[0] = nloc; b.st[1] = nx; }
        const unsigned old = xb_add(&bar[XB_XSUB(b.x)], 1u);
        const unsigned gen = old / nloc;
        if (old + 1u == (gen + 1u) * nloc) {
            __builtin_amdgcn_fence(__ATOMIC_RELEASE, "agent");
            asm volatile("s_waitcnt vmcnt(0)" ::: "memory");
            const unsigned og = xb_add(&bar[XB_TOP], 1u);
            const unsigned tg = og / nx;
            if (og + 1u == (tg + 1u) * nx) xb_add(&bar[XB_TOPGEN], 1u);
            else XB_SPIN(xb_ld(&bar[XB_TOPGEN]) == tg, bar);
            __builtin_amdgcn_fence(__ATOMIC_ACQUIRE, "agent");
            xb_add(&bar[XB_XGEN(b.x)], 1u);
            asm volatile("s_waitcnt vmcnt(0)" ::: "memory");
        } else {
            XB_SPIN(xb_ld(&bar[XB_XGEN(b.x)]) == gen, bar);
            __builtin_amdgcn_fence(__ATOMIC_ACQUIRE, "agent");
            asm volatile("s_waitcnt vmcnt(0)" ::: "memory");
        }
    }
    __syncthreads();
}

struct Args {
    const float *x, *norm_gain, *w_in, *b_gate, *conv_w, *a_log, *dt_bias, *dn_out_gain, *sb_q_gain, *sb_k_gain, *w_up_a, *w_up_b, *w_out;
    float* out; unsigned char* ws; int never; int pad;
};

__device__ __forceinline__ void p0_transpose_item(const float* W, int ldw, int src_col0, int k0, bf16_t* WT, int dst_row0, int dst_k0, LAS float* scr, int lane) {
#pragma unroll 8
    for (int i = 0; i < 32; ++i) { const int kk = 2 * i + (lane >> 5); scr[kk * 33 + (lane & 31)] = W[(size_t)(k0 + kk) * ldw + src_col0 + (lane & 31)]; }
    asm volatile("s_waitcnt lgkmcnt(0)" ::: "memory");
    const int c = lane & 7;
#pragma unroll
    for (int j = 0; j < 4; ++j) { const int n = (lane >> 3) + 8 * j; const LAS float* s = scr + (8 * c) * 33 + n;
        u32x4 o; o.x = cvt_pk_bf16(s[0 * 33], s[1 * 33]); o.y = cvt_pk_bf16(s[2 * 33], s[3 * 33]); o.z = cvt_pk_bf16(s[4 * 33], s[5 * 33]); o.w = cvt_pk_bf16(s[6 * 33], s[7 * 33]);
        *(u32x4*)(WT + (size_t)(dst_row0 + n) * 1024 + dst_k0 + 8 * c) = o; }
    asm volatile("s_waitcnt lgkmcnt(0)" ::: "memory");
}


#define MFMA16(a, b, c) __builtin_amdgcn_mfma_f32_16x16x32_bf16((a), (b), (c), 0, 0, 0)
__device__ __forceinline__ bf16x8 pack8(const f32x4 lo, const f32x4 hi) {
    u32x4 w;
    asm volatile("s_nop 7\n\ts_nop 7\n\ts_nop 3\n\tv_cvt_pk_bf16_f32 %0, %4, %5\n\tv_cvt_pk_bf16_f32 %1, %6, %7\n\tv_cvt_pk_bf16_f32 %2, %8, %9\n\tv_cvt_pk_bf16_f32 %3, %10, %11\n\ts_nop 1"
                 : "=&v"(w.x), "=&v"(w.y), "=&v"(w.z), "=&v"(w.w) : "v"(lo[0]), "v"(lo[1]), "v"(lo[2]), "v"(lo[3]), "v"(hi[0]), "v"(hi[1]), "v"(hi[2]), "v"(hi[3]));
    return __builtin_bit_cast(bf16x8, w);
}
#define LDS_FENCE() asm volatile("s_waitcnt lgkmcnt(0)" ::: "memory")

__device__ __forceinline__ void dn_rows_load(const bf16_t* QKVA, size_t row0, int col0, int lane, u32x4 (&r)[8]) {
    const bf16_t* rp = QKVA + (row0 + lane) * 1536 + col0;
#pragma unroll
    for (int grp = 0; grp < 8; ++grp) r[grp] = *(const u32x4*)(rp + 8 * grp);
}
__device__ __forceinline__ void dn_rows_to_lds(const u32x4 (&r)[8], LAS bf16_t* XT, int lane) {
#pragma unroll
    for (int grp = 0; grp < 8; ++grp) { const u32x4 w = r[grp]; LAS bf16_t* d = XT + (8 * grp) * 72 + lane;
        d[0 * 72] = (bf16_t)(w.x & 0xffffu); d[1 * 72] = (bf16_t)(w.x >> 16); d[2 * 72] = (bf16_t)(w.y & 0xffffu); d[3 * 72] = (bf16_t)(w.y >> 16);
        d[4 * 72] = (bf16_t)(w.z & 0xffffu); d[5 * 72] = (bf16_t)(w.z >> 16); d[6 * 72] = (bf16_t)(w.w & 0xffffu); d[7 * 72] = (bf16_t)(w.w >> 16); }
}

__device__ __forceinline__ void dn_prep(int task, LAS unsigned char* L, const bf16_t* QKVA, const float* BG, unsigned char* REC, bf16_t* UF, float* GE, int lane) {
    const int n = task & 31, h = (task >> 5) & 3, b = task >> 7;
    const size_t row0 = (size_t)b * SEQ + n * 64;
    LAS bf16_t* Mm = (LAS bf16_t*)L; LAS bf16_t* TT = (LAS bf16_t*)L;
    LAS bf16_t* XT = (LAS bf16_t*)(L + 8192);
    LAS float* GC = (LAS float*)(L + 17408); LAS float* BT = GC + 64; LAS float* DSC = GC + 128; LAS float* EGC = GC + 192;
    const int fr = lane & 15, fq = lane >> 4;
    unsigned char* rec = REC + (size_t)task * REC_BYTES;
    bf16x8 kf[4][4];
#pragma unroll
    for (int mt = 0; mt < 4; ++mt)
#pragma unroll
        for (int ks = 0; ks < 4; ++ks) { const bf16_t* rp = QKVA + (row0 + 16 * mt + fr) * 1536 + 128 * h + 32 * ks + 4 * fq + 512;
            const u32x2 kl = *(const u32x2*)(rp), kh = *(const u32x2*)(rp + 16);
            u32x4 kw; kw.x = kl.x; kw.y = kl.y; kw.z = kh.x; kw.w = kh.y; kf[mt][ks] = __builtin_bit_cast(bf16x8, kw); }
    u32x4 qnx[4];
#pragma unroll
    for (int ks = 0; ks < 4; ++ks) { const bf16_t* rp = QKVA + (row0 + fr) * 1536 + 128 * h + 32 * ks + 4 * fq; const u32x2 ql = *(const u32x2*)(rp), qh = *(const u32x2*)(rp + 16); qnx[ks].x = ql.x; qnx[ks].y = ql.y; qnx[ks].z = qh.x; qnx[ks].w = qh.y; }
    const float g = __hip_atomic_load(BG + (row0 + lane) * 8 + 4 + h, __ATOMIC_RELAXED, __HIP_MEMORY_SCOPE_AGENT), beta = __hip_atomic_load(BG + (row0 + lane) * 8 + h, __ATOMIC_RELAXED, __HIP_MEMORY_SCOPE_AGENT);
    float gc = g;
#pragma unroll
    for (int o = 1; o < 64; o <<= 1) { const float v = __shfl_up(gc, o); if (lane >= o) gc += v; }
    const float gl = __shfl(gc, 63);
    const float egc = __expf(gc);
    GC[lane] = gc; BT[lane] = beta; DSC[lane] = __expf(gl - gc); EGC[lane] = egc;
    if (lane == 0) GE[task] = __expf(gl);
    LDS_FENCE();
#pragma unroll
    for (int nt = 0; nt < 4; ++nt) { const float gci = GC[16 * nt + fr], sc = EGC[16 * nt + fr]; const int ic = 16 * nt + fr;
        bf16x8 qf[4]; u32x4 qw[4];
#pragma unroll
        for (int ks = 0; ks < 4; ++ks) qw[ks] = qnx[ks];
        if (nt < 3) {
#pragma unroll
            for (int ks = 0; ks < 4; ++ks) { const bf16_t* rp = QKVA + (row0 + 16 * (nt + 1) + fr) * 1536 + 128 * h + 32 * ks + 4 * fq; const u32x2 ql = *(const u32x2*)(rp), qh = *(const u32x2*)(rp + 16); qnx[ks].x = ql.x; qnx[ks].y = ql.y; qnx[ks].z = qh.x; qnx[ks].w = qh.y; } }
#pragma unroll
        for (int ks = 0; ks < 4; ++ks) { const u32x4 w = qw[ks]; qf[ks] = __builtin_bit_cast(bf16x8, w); u32x4 o;
            o.x = cvt_pk_safe(bflo(w.x) * sc, bfhi(w.x) * sc); o.y = cvt_pk_safe(bflo(w.y) * sc, bfhi(w.y) * sc); o.z = cvt_pk_safe(bflo(w.z) * sc, bfhi(w.z) * sc); o.w = cvt_pk_safe(bflo(w.w) * sc, bfhi(w.w) * sc);
            *(u32x4*)(rec + 16384 + ((ks * 4 + nt) * 64 + lane) * 16) = o; }
#pragma unroll
        for (int ks2 = 0; ks2 < 2; ++ks2) { f32x4 d0 = {0.f, 0.f, 0.f, 0.f}, d1 = {0.f, 0.f, 0.f, 0.f};
#pragma unroll
            for (int ks = 0; ks < 4; ++ks) { d0 = MFMA16(kf[2 * ks2][ks], qf[ks], d0); d1 = MFMA16(kf[2 * ks2 + 1][ks], qf[ks], d1); }
            const f32x4 gj0 = *(const LAS f32x4*)(GC + 32 * ks2 + 4 * fq), gj1 = *(const LAS f32x4*)(GC + 32 * ks2 + 16 + 4 * fq);
#pragma unroll
            for (int r = 0; r < 4; ++r) { const int j0 = 32 * ks2 + 4 * fq + r;
                d0[r] = (j0 <= ic) ? d0[r] * __expf(gci - gj0[r]) : 0.f; d1[r] = (j0 + 16 <= ic) ? d1[r] * __expf(gci - gj1[r]) : 0.f; }
            *(bf16x8*)(rec + 49152 + ((ks2 * 4 + nt) * 64 + lane) * 16) = pack8(d0, d1); }
        __builtin_amdgcn_sched_barrier(0); }
#pragma unroll
    for (int mt = 0; mt < 4; ++mt)
#pragma unroll
        for (int nt = 0; nt <= mt; ++nt) { f32x4 d = {0.f, 0.f, 0.f, 0.f};
#pragma unroll
            for (int ks = 0; ks < 4; ++ks) d = MFMA16(kf[mt][ks], kf[nt][ks], d);
            const float gcj = GC[16 * nt + fr]; const f32x4 gi = *(const LAS f32x4*)(GC + 16 * mt + 4 * fq), bi = *(const LAS f32x4*)(BT + 16 * mt + 4 * fq);
#pragma unroll
            for (int r = 0; r < 4; r += 2) { const int i = 16 * mt + 4 * fq + r, j = 16 * nt + fr; const float v0 = (j < i) ? bi[r] * d[r] * __expf(gi[r] - gcj) : 0.f, v1 = (j < i + 1) ? bi[r + 1] * d[r + 1] * __expf(gi[r + 1] - gcj) : 0.f;
                const unsigned w = cvt_pk_safe(v0, v1); Mm[i * 64 + j] = (bf16_t)(w & 0xffffu); Mm[(i + 1) * 64 + j] = (bf16_t)(w >> 16); } }
    __builtin_amdgcn_sched_barrier(0);
    u32x4 xr[8];
    dn_rows_load(QKVA, row0, 512 + 128 * h, lane, xr);
    LDS_FENCE();
    float t[64];
#define INV_ROWS(I0) _Pragma("unroll") for (int i = (I0); i < (I0) + 16; ++i) { float acc = (lane == i) ? 1.f : 0.f; \
        _Pragma("unroll") for (int jj = 0; jj < (i + 7) / 8; ++jj) { const u32x4 mv = *(const LAS u32x4*)(Mm + i * 64 + 8 * jj); \
            if (8 * jj + 0 < i) acc -= bflo(mv.x) * t[8 * jj + 0]; if (8 * jj + 1 < i) acc -= bfhi(mv.x) * t[8 * jj + 1]; if (8 * jj + 2 < i) acc -= bflo(mv.y) * t[8 * jj + 2]; if (8 * jj + 3 < i) acc -= bfhi(mv.y) * t[8 * jj + 3]; \
            if (8 * jj + 4 < i) acc -= bflo(mv.z) * t[8 * jj + 4]; if (8 * jj + 5 < i) acc -= bfhi(mv.z) * t[8 * jj + 5]; if (8 * jj + 6 < i) acc -= bflo(mv.w) * t[8 * jj + 6]; if (8 * jj + 7 < i) acc -= bfhi(mv.w) * t[8 * jj + 7]; } \
        t[i] = acc; }
    INV_ROWS(0) INV_ROWS(16) INV_ROWS(32) INV_ROWS(48)
#undef INV_ROWS
    LDS_FENCE();
    { const float s1 = beta * egc;
#pragma unroll
      for (int i = 0; i < 64; i += 2) { const unsigned w1 = cvt_pk_bf16(t[i] * s1, t[i + 1] * s1); TT[i * 64 + lane] = (bf16_t)(w1 & 0xffffu); TT[(i + 1) * 64 + lane] = (bf16_t)(w1 >> 16); } }
#pragma unroll
    for (int hf = 0; hf < 2; ++hf) {
        LDS_FENCE();
        dn_rows_to_lds(xr, XT, lane);
        if (hf == 0) dn_rows_load(QKVA, row0, 512 + 128 * h + 64, lane, xr); else dn_rows_load(QKVA, row0, 1024 + 128 * h, lane, xr);
        LDS_FENCE();
#pragma unroll
        for (int ks2 = 0; ks2 < 2; ++ks2) { const f32x4 s0 = *(const LAS f32x4*)(DSC + 32 * ks2 + 4 * fq), s1 = *(const LAS f32x4*)(DSC + 32 * ks2 + 16 + 4 * fq);
#pragma unroll
            for (int m4 = 0; m4 < 4; ++m4) { const LAS bf16_t* p = XT + (16 * m4 + fr) * 72 + 32 * ks2 + 4 * fq;
                const u32x2 lo = *(const LAS u32x2*)p, hi = *(const LAS u32x2*)(p + 16); u32x4 o;
                o.x = cvt_pk_bf16(bflo(lo.x) * s0[0], bfhi(lo.x) * s0[1]); o.y = cvt_pk_bf16(bflo(lo.y) * s0[2], bfhi(lo.y) * s0[3]);
                o.z = cvt_pk_bf16(bflo(hi.x) * s1[0], bfhi(hi.x) * s1[1]); o.w = cvt_pk_bf16(bflo(hi.y) * s1[2], bfhi(hi.y) * s1[3]);
                *(u32x4*)(rec + 32768 + ((ks2 * 8 + 4 * hf + m4) * 64 + lane) * 16) = o; } }
#pragma unroll
        for (int nt = 0; nt < 4; ++nt) { bf16x8 tb[2];
#pragma unroll
            for (int ks2 = 0; ks2 < 2; ++ks2) tb[ks2] = *(const LAS bf16x8*)(TT + (16 * nt + fr) * 64 + 32 * ks2 + 8 * fq);
            f32x4 d[4];
#pragma unroll
            for (int m4 = 0; m4 < 4; ++m4) { d[m4] = (f32x4){0.f, 0.f, 0.f, 0.f};
#pragma unroll
                for (int ks2 = 0; ks2 < 2; ++ks2) d[m4] = MFMA16(*(const LAS bf16x8*)(XT + (16 * m4 + fr) * 72 + 32 * ks2 + 8 * fq), tb[ks2], d[m4]); }
#pragma unroll
            for (int kl = 0; kl < 2; ++kl) *(bf16x8*)(rec + (((2 * hf + kl) * 4 + nt) * 64 + lane) * 16) = pack8(-d[2 * kl], -d[2 * kl + 1]); }
    }
    LDS_FENCE();
    {
#pragma unroll
      for (int i = 0; i < 64; i += 2) { const unsigned w2 = cvt_pk_bf16(t[i] * beta, t[i + 1] * beta); TT[i * 64 + lane] = (bf16_t)(w2 & 0xffffu); TT[(i + 1) * 64 + lane] = (bf16_t)(w2 >> 16); } }
    bf16_t* uf = UF + (size_t)task * 8192;
#pragma unroll
    for (int hf = 0; hf < 2; ++hf) {
        LDS_FENCE();
        dn_rows_to_lds(xr, XT, lane);
        if (hf == 0) dn_rows_load(QKVA, row0, 1024 + 128 * h + 64, lane, xr);
        LDS_FENCE();
#pragma unroll
        for (int mt = 0; mt < 4; ++mt) { bf16x8 ta[2];
#pragma unroll
            for (int ks2 = 0; ks2 < 2; ++ks2) ta[ks2] = *(const LAS bf16x8*)(TT + (16 * mt + fr) * 64 + 32 * ks2 + 8 * fq);
#pragma unroll
            for (int n4 = 0; n4 < 4; ++n4) { f32x4 d = {0.f, 0.f, 0.f, 0.f};
#pragma unroll
                for (int ks2 = 0; ks2 < 2; ++ks2) d = MFMA16(ta[ks2], *(const LAS bf16x8*)(XT + (16 * n4 + fr) * 72 + 32 * ks2 + 8 * fq), d);
                u32x2 o; o.x = cvt_pk_safe(d[0], d[1]); o.y = cvt_pk_safe(d[2], d[3]); *(u32x2*)(uf + (((4 * hf + n4) * 4 + mt) * 64 + lane) * 4) = o; } }
    }
    LDS_FENCE();
}

#define SCAN_BAR() do { asm volatile("s_waitcnt lgkmcnt(0)" ::: "memory"); __builtin_amdgcn_s_barrier(); asm volatile("" ::: "memory"); } while (0)
__device__ __forceinline__ void dn_scan_wg(int unit, LAS unsigned char* lds, const unsigned char* REC, const bf16_t* UF, const float* GE, bf16_t* ORAW, int tid, int wave, int lane) {
    const int bh = unit, b = bh >> 2, h = bh & 3;
    const int fr = lane & 15, fq = lane >> 4;
    constexpr int IMG = REC_BYTES + 16384;
    if (wave >= 4) {
        const int lt = tid - 256; const unsigned char* rbase = REC + (size_t)(bh * 32) * REC_BYTES + lt * 16; const unsigned char* ubase = (const unsigned char*)UF + (size_t)(bh * 32) * 16384 + lt * 16;
        u32x4 A[18], B[18];
#define LREC(dst, r) do { const unsigned char* _p = rbase + (size_t)(r) * REC_BYTES; const unsigned char* _u = ubase + (size_t)(r) * 16384; \
            _Pragma("unroll") for (int _c = 0; _c < 14; ++_c) dst[_c] = *(const u32x4*)(_p + _c * 4096); _Pragma("unroll") for (int _c = 0; _c < 4; ++_c) dst[14 + _c] = *(const u32x4*)(_u + _c * 4096); } while (0)
#define SREC(src, buf) do { _Pragma("unroll") for (int _c = 0; _c < 18; ++_c) *(LAS u32x4*)(lds + (buf) * IMG + _c * 4096 + lt * 16) = src[_c]; } while (0)
        LREC(B, 0); LREC(A, 1);
        SREC(B, 0);
        SCAN_BAR();
        for (int n = 0; n < 32; n += 2) {
            if (n + 2 < 32) LREC(B, n + 2);
            SREC(A, (n + 1) & 1);
            SCAN_BAR();
            if (n + 3 < 32) LREC(A, n + 3);
            if (n + 2 < 32) SREC(B, (n + 2) & 1);
            SCAN_BAR();
        }
#undef LREC
#undef SREC
        return;
    }
    const int sl0 = 2 * wave;
    f32x4 S[2][8]; bf16x8 Sb[2][4];
#pragma unroll
    for (int cg = 0; cg < 2; ++cg) {
#pragma unroll
        for (int i = 0; i < 8; ++i) S[cg][i] = (f32x4){0.f, 0.f, 0.f, 0.f};
#pragma unroll
        for (int i = 0; i < 4; ++i) Sb[cg][i] = (bf16x8){0, 0, 0, 0, 0, 0, 0, 0}; }
    const float gev = GE[bh * 32 + (lane & 31)];
    float ge_all = gev; asm volatile("s_waitcnt vmcnt(0)" : "+v"(ge_all) :: "memory");
    SCAN_BAR();
    for (int n = 0; n < 32; ++n) {
        const LAS unsigned char* img = lds + (n & 1) * IMG;
        const LAS unsigned char* rec = img + lane * 16;
        const float ge = __shfl(ge_all, n);
        f32x4 vn[2][4];
#pragma unroll
        for (int cg = 0; cg < 2; ++cg)
#pragma unroll
            for (int mt = 0; mt < 4; ++mt) { const u32x2 uu = *(const LAS u32x2*)(img + REC_BYTES + (((sl0 + cg) * 4 + mt) * 64 + lane) * 8); vn[cg][mt] = (f32x4){bflo(uu.x), bfhi(uu.x), bflo(uu.y), bfhi(uu.y)}; }
        bf16x8 fa[4], fb[4];
#define LDF(dst, off) do { _Pragma("unroll") for (int _i = 0; _i < 4; ++_i) dst[_i] = *(const LAS bf16x8*)(rec + (off) + _i * 1024); } while (0)
#define MM4(accv, fr_, bsel) do { _Pragma("unroll") for (int _i = 0; _i < 4; ++_i) { accv[0][_i] = MFMA16(fr_[_i], bsel(0), accv[0][_i]); accv[1][_i] = MFMA16(fr_[_i], bsel(1), accv[1][_i]); } } while (0)
#define SBK0(cg) Sb[cg][0]
#define SBK1(cg) Sb[cg][1]
#define SBK2(cg) Sb[cg][2]
#define SBK3(cg) Sb[cg][3]
#define VBK0(cg) Vb[cg][0]
#define VBK1(cg) Vb[cg][1]
        LDF(fa, 0); LDF(fb, 4096);
        MM4(vn, fa, SBK0); LDF(fa, 8192);
        MM4(vn, fb, SBK1); LDF(fb, 12288);
        MM4(vn, fa, SBK2); LDF(fa, 16384);
        MM4(vn, fb, SBK3); LDF(fb, 16384 + 4096);
        bf16x8 Vb[2][2];
#pragma unroll
        for (int cg = 0; cg < 2; ++cg) { Vb[cg][0] = pack8(vn[cg][0], vn[cg][1]); Vb[cg][1] = pack8(vn[cg][2], vn[cg][3]); }
        f32x4 o[2][4];
#pragma unroll
        for (int cg = 0; cg < 2; ++cg)
#pragma unroll
            for (int mt = 0; mt < 4; ++mt) o[cg][mt] = (f32x4){0.f, 0.f, 0.f, 0.f};
        MM4(o, fa, SBK0);  LDF(fa, 16384 + 8192);
        MM4(o, fb, SBK1);  LDF(fb, 16384 + 12288);
        MM4(o, fa, SBK2);  LDF(fa, 49152);
        MM4(o, fb, SBK3);  LDF(fb, 49152 + 4096);
        MM4(o, fa, VBK0);  LDF(fa, 32768);
        MM4(o, fb, VBK1);  LDF(fb, 32768 + 4096);
#pragma unroll
        for (int i = 0; i < 4; ++i) { S[0][i] = MFMA16(fa[i], Vb[0][0], S[0][i] * ge); S[1][i] = MFMA16(fa[i], Vb[1][0], S[1][i] * ge); }
        LDF(fa, 32768 + 8192);
#pragma unroll
        for (int i = 0; i < 4; ++i) { S[0][4 + i] = MFMA16(fb[i], Vb[0][0], S[0][4 + i] * ge); S[1][4 + i] = MFMA16(fb[i], Vb[1][0], S[1][4 + i] * ge); }
        LDF(fb, 32768 + 12288);
#pragma unroll
        for (int cg = 0; cg < 2; ++cg) { bf16_t* op = ORAW + ((size_t)b * SEQ + 64 * n + 4 * fq) * 512 + 128 * h + 16 * (sl0 + cg) + fr;
#pragma unroll
            for (int mt = 0; mt < 4; ++mt) { const unsigned w0 = cvt_pk_safe(o[cg][mt][0], o[cg][mt][1]), w1 = cvt_pk_safe(o[cg][mt][2], o[cg][mt][3]);
                op[(16 * mt + 0) * 512] = (bf16_t)(w0 & 0xffffu); op[(16 * mt + 1) * 512] = (bf16_t)(w0 >> 16); op[(16 * mt + 2) * 512] = (bf16_t)(w1 & 0xffffu); op[(16 * mt + 3) * 512] = (bf16_t)(w1 >> 16); } }
#pragma unroll
        for (int i = 0; i < 4; ++i) { S[0][i] = MFMA16(fa[i], Vb[0][1], S[0][i]); S[1][i] = MFMA16(fa[i], Vb[1][1], S[1][i]); }
#pragma unroll
        for (int i = 0; i < 4; ++i) { S[0][4 + i] = MFMA16(fb[i], Vb[0][1], S[0][4 + i]); S[1][4 + i] = MFMA16(fb[i], Vb[1][1], S[1][4 + i]); }
#undef LDF
#undef MM4
#pragma unroll
        for (int cg = 0; cg < 2; ++cg)
#pragma unroll
            for (int ks = 0; ks < 4; ++ks) Sb[cg][ks] = pack8(S[cg][2 * ks], S[cg][2 * ks + 1]);
        SCAN_BAR();
    }
}

typedef float f32x16 __attribute__((ext_vector_type(16)));
#define MFMA32(a, b, c) __builtin_amdgcn_mfma_f32_32x32x16_bf16((a), (b), (c), 0, 0, 0)
__device__ __forceinline__ void attn_task(int task, bf16_t* P1, int lane) {
    const int qb = task & 63, h = (task >> 6) & 7, b = task >> 9;
    const int r32 = lane & 31, hi = lane >> 5;
    const int q0 = qb * 32, qi = q0 + r32;
    bf16_t* base = P1 + (size_t)b * SEQ * N1 + 64 * h;
    bf16x8 qf[4];
#pragma unroll
    for (int c = 0; c < 4; ++c) qf[c] = *(const bf16x8*)(base + (size_t)qi * N1 + 2048 + 16 * c + 8 * hi);
    bf16x8 ua0, ua1, ones;
#pragma unroll
    for (int e = 0; e < 8; ++e) { const int key0 = 8 * (e >> 2) + 4 * hi + (e & 3); ua0[e] = (key0 > r32) ? (short)0x3F80 : (short)0; ua1[e] = (16 + key0 > r32) ? (short)0x3F80 : (short)0; ones[e] = (short)0x3F80; }
    f32x16 o[2];
#pragma unroll
    for (int i = 0; i < 16; ++i) { o[0][i] = 0.f; o[1][i] = 0.f; }
    float R = 0.f;
    const int ktd = q0 >> 6;
    bf16x8 kn[2][4];
#define LOAD_KV(KT) do { _Pragma("unroll") for (int mt = 0; mt < 2; ++mt) _Pragma("unroll") for (int c = 0; c < 4; ++c) \
        kn[mt][c] = *(const bf16x8*)(base + (size_t)((KT) * 64 + 32 * mt + r32) * N1 + 2560 + 16 * c + 8 * hi); } while (0)
    LOAD_KV(ktd);
    for (int kt = ktd; kt >= 0; --kt) {
        const int k0 = kt * 64; const bool diag = (kt == ktd);
        bf16x8 kf[2][4], vf[2][4];
#pragma unroll
        for (int mt = 0; mt < 2; ++mt)
#pragma unroll
            for (int c = 0; c < 4; ++c) { kf[mt][c] = kn[mt][c]; vf[mt][c] = *(const bf16x8*)(base + (size_t)((32 * mt + r32) * 32 + kt) * N1 + 3072 + 16 * c + 8 * hi); }
        if (kt > 0) LOAD_KV(kt - 1);
        f32x16 p[2];
#pragma unroll
        for (int i = 0; i < 16; ++i) { p[0][i] = 0.f; p[1][i] = 0.f; }
#pragma unroll
        for (int c = 0; c < 4; ++c) { p[0] = MFMA32(kf[0][c], qf[c], p[0]); p[1] = MFMA32(kf[1][c], qf[c], p[1]); }
        f32x16 lk[2]; float rs = 0.f;
#pragma unroll
        for (int mt = 0; mt < 2; ++mt)
#pragma unroll
            for (int r = 0; r < 16; ++r) { const int key = k0 + 32 * mt + (r & 3) + 8 * (r >> 2) + 4 * hi; const float z = p[mt][r];
                const float e = __builtin_amdgcn_exp2f(-fabsf(z)); const float sp = fmaxf(z, 0.f) + __builtin_amdgcn_logf(1.0f + e);
                const bool valid = !diag || key < qi; const float l = valid ? -sp : 0.f; lk[mt][r] = l; p[mt][r] = z - sp; rs += l; }
        bf16x8 lh[4];
#pragma unroll
        for (int kc = 0; kc < 4; ++kc) { u32x4 wh;
#pragma unroll
            for (int e2 = 0; e2 < 4; ++e2) wh[e2] = cvt_pk_bf16(lk[kc >> 1][8 * (kc & 1) + 2 * e2], lk[kc >> 1][8 * (kc & 1) + 2 * e2 + 1]);
            lh[kc] = __builtin_bit_cast(bf16x8, wh); }
        f32x16 cum[2];
#pragma unroll
        for (int i = 0; i < 16; ++i) { cum[0][i] = 0.f; cum[1][i] = 0.f; }
        cum[0] = MFMA32(ua0, lh[0], cum[0]); cum[0] = MFMA32(ua1, lh[1], cum[0]); cum[0] = MFMA32(ones, lh[2], cum[0]); cum[0] = MFMA32(ones, lh[3], cum[0]);
        cum[1] = MFMA32(ua0, lh[2], cum[1]); cum[1] = MFMA32(ua1, lh[3], cum[1]);
        bf16x8 pb[4];
#pragma unroll
        for (int kc = 0; kc < 4; ++kc) { u32x4 w; const int mt = kc >> 1;
#pragma unroll
            for (int e2 = 0; e2 < 4; ++e2) { const int ra = 8 * (kc & 1) + 2 * e2, rb = ra + 1;
                const int keya = k0 + 32 * mt + (ra & 3) + 8 * (ra >> 2) + 4 * hi, keyb = k0 + 32 * mt + (rb & 3) + 8 * (rb >> 2) + 4 * hi;
                float wa = __builtin_amdgcn_exp2f(p[mt][ra] + cum[mt][ra] + R), wb = __builtin_amdgcn_exp2f(p[mt][rb] + cum[mt][rb] + R);
                wa = (!diag || keya < qi) ? wa : 0.f; wb = (!diag || keyb < qi) ? wb : 0.f;
                w[e2] = cvt_pk_bf16(wa, wb); }
            pb[kc] = __builtin_bit_cast(bf16x8, w); }
#pragma unroll
        for (int kc = 0; kc < 4; ++kc) { o[0] = MFMA32(vf[0][kc], pb[kc], o[0]); o[1] = MFMA32(vf[1][kc], pb[kc], o[1]); }
        rs += __shfl_xor(rs, 32); R += rs;
        if (__ballot(R >= -150.f) == 0ull) break;
    }
#undef LOAD_KV
    bf16_t* qrow = base + (size_t)qi * N1 + 2048; const bf16_t* zrow = base + (size_t)qi * N1 + 3584;
#pragma unroll
    for (int mt = 0; mt < 2; ++mt)
#pragma unroll
        for (int g = 0; g < 4; ++g) { const int d = 32 * mt + 8 * g + 4 * hi; const u32x2 zz = *(const u32x2*)(zrow + d);
            const float v0 = o[mt][4 * g] * bflo(zz.x), v1 = o[mt][4 * g + 1] * bfhi(zz.x), v2 = o[mt][4 * g + 2] * bflo(zz.y), v3 = o[mt][4 * g + 3] * bfhi(zz.y);
            u32x2 w; w.x = cvt_pk_bf16(v0, v1); w.y = cvt_pk_bf16(v2, v3); *(u32x2*)(qrow + d) = w; }
}
__device__ __forceinline__ void attn_queue(unsigned* ctr, bf16_t* P1, int lane) {
    for (;;) { unsigned tk = 0; if (lane == 0) tk = atomicAdd(ctr, 1u); tk = (unsigned)__builtin_amdgcn_readfirstlane((int)tk); if (tk >= 16u * 8u * 64u) break; attn_task((int)tk, P1, lane); }
}

__global__ void __launch_bounds__(512, 2) fwd(Args a) {
    extern __shared__ __attribute__((aligned(16))) unsigned char lds_raw[];
    LAS unsigned char* lds = (LAS unsigned char*)lds_raw;
    cg::grid_group grid = cg::this_grid();
    const int tid = threadIdx.x, lane = tid & 63, wave = __builtin_amdgcn_readfirstlane(tid >> 6);
    const int G = gridDim.x, gw = blockIdx.x * NWAVES + wave, NGW = G * NWAVES;
    unsigned char* ws = a.ws;
    if (tid < 64) ((LAS unsigned*)(lds + 147456))[tid] = 0u;
    __syncthreads();
    XcdBarrier bar = xcd_barrier_post((unsigned*)(ws + WS_BAR), (volatile LAS unsigned*)(lds + 147456));
    bf16_t* W1T = (bf16_t*)(ws + WS_W1T); bf16_t* WGT = (bf16_t*)(ws + WS_WGT); bf16_t* WUPT = (bf16_t*)(ws + WS_WUPT); bf16_t* WOT = (bf16_t*)(ws + WS_WOT);
    float* BG = (float*)(ws + WS_BG); bf16_t* XN = (bf16_t*)(ws + WS_XN); bf16_t* P1 = (bf16_t*)(ws + WS_P1);
    bf16_t* QKVA = (bf16_t*)(ws + WS_QKVA); bf16_t* ORAW = (bf16_t*)(ws + WS_ORAW); bf16_t* MG = (bf16_t*)(ws + WS_MG);
    bf16_t* GSC = (bf16_t*)(ws + WS_GSC) + (size_t)blockIdx.x * 65536; bf16_t* GY = (bf16_t*)((unsigned char*)a.out + OUT_GY) + (size_t)blockIdx.x * 65536;

    {
        if (blockIdx.x == 0 && tid == 0) *(unsigned*)(ws + WS_CTL) = 0u;
        LAS float* scr = (LAS float*)(lds + wave * 8704);
        LAS float* W8T = (LAS float*)(lds + 69632);
        for (int i = 0; i < 16; ++i) { const int idx = tid + 512 * i, c = idx & 7, d = idx >> 3; W8T[c * 1024 + d] = a.w_in[(size_t)d * PROJ + 2048 + c]; }
        for (int it = gw; it < 4096; it += NGW) {
            int r = it;
            if (r < 2048) { const int kb = r >> 7, nb = r & 127, pn = nb >> 3, p0 = 32 * (nb & 7); const int logical = pn * 256 + 64 * ((p0 >> 5) & 3) + 32 * (p0 >> 7);
                const int src = logical < 2048 ? logical : logical + 8;
                p0_transpose_item(a.w_in, PROJ, src, 64 * kb, W1T, 32 * nb, 64 * kb, scr, lane); continue; }
            r -= 2048;
            if (r < 1024) { const int kb = r >> 6, nb = r & 63; p0_transpose_item(a.w_in, PROJ, 4104 + 32 * nb, 64 * kb, WGT, 32 * nb, 64 * kb, scr, lane); continue; }
            r -= 1024;
            if (r < 256) { const int kb = r >> 5, nb = r & 31; p0_transpose_item(a.w_up_a, DM, 32 * nb, 64 * kb, WUPT, 32 * nb, 64 * kb, scr, lane); continue; }
            r -= 256;
            if (r < 256) { const int kb = r >> 5, nb = r & 31; p0_transpose_item(a.w_up_b, DM, 32 * nb, 64 * kb, WUPT, 32 * nb, 512 + 64 * kb, scr, lane); continue; }
            r -= 256;
            { const int kb = r >> 5, nb = r & 31; p0_transpose_item(a.w_out, DM, 32 * nb, 64 * kb, WOT, 32 * nb, 64 * kb, scr, lane); }
        }
        __syncthreads();
        f32x4 gv[4];
#pragma unroll
        for (int j = 0; j < 4; ++j) gv[j] = ((const f32x4*)a.norm_gain)[lane + 64 * j];
        for (int rb = gw * 4; rb < M; rb += NGW * 4) {
            f32x4 v[4][4]; float ss[4];
#pragma unroll
            for (int q = 0; q < 4; ++q) { const f32x4* xr = (const f32x4*)(a.x + (size_t)(rb + q) * DM) + lane; ss[q] = 0.f;
#pragma unroll
                for (int j = 0; j < 4; ++j) { v[q][j] = xr[64 * j]; } }
#pragma unroll
            for (int q = 0; q < 4; ++q)
#pragma unroll
                for (int j = 0; j < 4; ++j) ss[q] += (v[q][j][0] * v[q][j][0] + v[q][j][1] * v[q][j][1]) + (v[q][j][2] * v[q][j][2] + v[q][j][3] * v[q][j][3]);
#pragma unroll
            for (int o = 1; o < 64; o <<= 1) {
#pragma unroll
                for (int q = 0; q < 4; ++q) ss[q] += __shfl_xor(ss[q], o); }
            float bg[4][8];
#pragma unroll
            for (int q = 0; q < 4; ++q) { const float rstd = __builtin_amdgcn_rsqf(ss[q] * (1.0f / DM) + EPS);
#pragma unroll
                for (int c = 0; c < 8; ++c) bg[q][c] = 0.f;
                u32x2* o8 = (u32x2*)(XN + (size_t)(rb + q) * DM) + lane;
#pragma unroll
                for (int j = 0; j < 4; ++j) { v[q][j] = v[q][j] * rstd * gv[j]; u32x2 w; w.x = cvt_pk_bf16(v[q][j][0], v[q][j][1]); w.y = cvt_pk_bf16(v[q][j][2], v[q][j][3]); o8[64 * j] = w; } }
#pragma unroll
            for (int j = 0; j < 4; ++j)
#pragma unroll
                for (int c = 0; c < 8; ++c) { const f32x4 wv = *(const LAS f32x4*)(W8T + c * 1024 + 4 * lane + 256 * j);
#pragma unroll
                    for (int q = 0; q < 4; ++q) bg[q][c] += (v[q][j][0] * wv[0] + v[q][j][1] * wv[1]) + (v[q][j][2] * wv[2] + v[q][j][3] * wv[3]); }
#pragma unroll
            for (int q = 0; q < 4; ++q) { const bool b0 = lane & 1, b1 = lane & 2, b2 = lane & 4;
                float t4[4];
#pragma unroll
                for (int c = 0; c < 4; ++c) { const float snd = b0 ? bg[q][c] : bg[q][c + 4], keep = b0 ? bg[q][c + 4] : bg[q][c]; t4[c] = keep + __shfl_xor(snd, 1); }
                float t2[2];
#pragma unroll
                for (int c = 0; c < 2; ++c) { const float snd = b1 ? t4[c] : t4[c + 2], keep = b1 ? t4[c + 2] : t4[c]; t2[c] = keep + __shfl_xor(snd, 2); }
                float t1; { const float snd = b2 ? t2[0] : t2[1], keep = b2 ? t2[1] : t2[0]; t1 = keep + __shfl_xor(snd, 4); }
                t1 += __shfl_xor(t1, 8); t1 += __shfl_xor(t1, 16); t1 += __shfl_xor(t1, 32);
                if (lane < 8) BG[(size_t)(rb + q) * 8 + (b0 ? 4 : 0) + (b1 ? 2 : 0) + (b2 ? 1 : 0)] = t1; }
        }
    }
    if (a.never) grid.sync();
    xcd_barrier(bar);

    {
        pg8::SchedPlain S{(const char*)XN, (const char*)W1T, 16, 128, 16, G, (int)blockIdx.x};
        pg8::Epi1 E{P1, a.sb_q_gain, a.sb_k_gain};
        pg8::gemm_phase<pg8::Epi1, pg8::SchedPlain>(lds, S, E);
    }
    xcd_barrier(bar);

    {
        for (int run = gw; run < M / 16; run += NGW) {
            const int t0 = run * 16; const bool seq_start = (t0 % SEQ) == 0;
#pragma unroll
            for (int g = 0; g < 3; ++g) {
                float cw[4][8];
#pragma unroll
                for (int tp = 0; tp < 4; ++tp) { const f32x4 c0 = *(const f32x4*)(a.conv_w + tp * 1536 + 512 * g + 8 * lane), c1 = *(const f32x4*)(a.conv_w + tp * 1536 + 512 * g + 8 * lane + 4);
#pragma unroll
                    for (int e = 0; e < 4; ++e) { cw[tp][e] = c0[e]; cw[tp][4 + e] = c1[e]; } }
                u32x4 rows[19];
#pragma unroll
                for (int k = 0; k < 19; ++k) rows[k] = (k < 3 && seq_start) ? (u32x4){0u, 0u, 0u, 0u} : *(const u32x4*)(P1 + (size_t)(t0 - 3 + k) * N1 + 512 * g + 8 * lane);
#pragma unroll
                for (int tt = 0; tt < 16; ++tt) {
                    float val[8]; float ss = 0.f;
#pragma unroll
                    for (int e2 = 0; e2 < 4; ++e2) {
                        const unsigned w0 = rows[tt][e2], w1 = rows[tt + 1][e2], w2 = rows[tt + 2][e2], w3 = rows[tt + 3][e2];
                        float lo = cw[0][2 * e2] * bflo(w0) + cw[1][2 * e2] * bflo(w1) + cw[2][2 * e2] * bflo(w2) + cw[3][2 * e2] * bflo(w3);
                        float hi = cw[0][2 * e2 + 1] * bfhi(w0) + cw[1][2 * e2 + 1] * bfhi(w1) + cw[2][2 * e2 + 1] * bfhi(w2) + cw[3][2 * e2 + 1] * bfhi(w3);
                        lo = lo * sigmoidf_(lo); hi = hi * sigmoidf_(hi);
                        val[2 * e2] = lo; val[2 * e2 + 1] = hi; ss += lo * lo + hi * hi;
                    }
                    float sc = 1.f;
                    if (g < 2) { ss = red16(ss); sc = __builtin_amdgcn_rsqf(ss + EPS); if (g == 0) sc *= 0.08838834764831845f; }
                    u32x4 w; w.x = cvt_pk_bf16(val[0] * sc, val[1] * sc); w.y = cvt_pk_bf16(val[2] * sc, val[3] * sc); w.z = cvt_pk_bf16(val[4] * sc, val[5] * sc); w.w = cvt_pk_bf16(val[6] * sc, val[7] * sc);
                    *(u32x4*)(QKVA + (size_t)(t0 + tt) * 1536 + 512 * g + 8 * lane) = w;
                }
            }
            { const int tk = lane >> 2, hh = lane & 3; float* bgp = BG + (size_t)(t0 + tk) * 8; const float blv = bgp[hh], dlv = bgp[4 + hh];
              const float beta = sigmoidf_(blv); const float xx = dlv + a.dt_bias[hh]; const float sp = fmaxf(xx, 0.f) + log1pf(expf(-fabsf(xx)));
              const float gg = -expf(a.a_log[hh]) * sp; bgp[hh] = beta; bgp[4 + hh] = gg; }
        }
    }
    unsigned* actr = (unsigned*)(ws + WS_CTL);
    unsigned char* REC = (unsigned char*)a.out + OUT_REC; bf16_t* UF = (bf16_t*)(ws + WS_UF); float* GE = (float*)(ws + WS_GE);
    if (G == 256) { asm volatile("s_waitcnt vmcnt(0)" ::: "memory"); __syncthreads();
        const int bb = blockIdx.x >> 4, n0 = 2 * (blockIdx.x & 15); dn_prep((bb * 4 + (wave & 3)) * 32 + n0 + (wave >> 2), lds + wave * 18432, QKVA, BG, REC, UF, GE, lane); }
    else { xcd_barrier(bar); for (int task = blockIdx.x * 8 + wave; task < 2048; task += G * 8) dn_prep(task, lds + wave * 18432, QKVA, BG, REC, UF, GE, lane); }
    xcd_barrier(bar);

    if (G == 256) { if (((blockIdx.x >> 3) & 3) == 0) dn_scan_wg((blockIdx.x >> 5) * 8 + (blockIdx.x & 7), lds, REC, UF, GE, ORAW, tid, wave, lane); }
    else { for (int bh = blockIdx.x; bh < 64; bh += G) dn_scan_wg(bh, lds, REC, UF, GE, ORAW, tid, wave, lane); }
    attn_queue(actr, P1, lane);
    xcd_barrier(bar);

    {
        int lane4 = lane; asm volatile("" : "+v"(lane4));
        f32x4 g0 = *(const f32x4*)(a.dn_out_gain + ((8 * lane4) & 127)), g1 = *(const f32x4*)(a.dn_out_gain + ((8 * lane4) & 127) + 4);
        for (int rb = gw * 4; rb < M; rb += NGW * 4) {
            u32x4 ov4[4], zv4[4];
#pragma unroll
            for (int q = 0; q < 4; ++q) { ov4[q] = *(const u32x4*)(ORAW + (size_t)(rb + q) * 512 + 8 * lane); zv4[q] = *(const u32x4*)(P1 + (size_t)(rb + q) * N1 + 1536 + 8 * lane); }
#pragma unroll
            for (int q = 0; q < 4; ++q) { const u32x4 ov = ov4[q], zv = zv4[q];
                float v[8] = {bflo(ov.x), bfhi(ov.x), bflo(ov.y), bfhi(ov.y), bflo(ov.z), bfhi(ov.z), bflo(ov.w), bfhi(ov.w)};
                const float z[8] = {bflo(zv.x), bfhi(zv.x), bflo(zv.y), bfhi(zv.y), bflo(zv.z), bfhi(zv.z), bflo(zv.w), bfhi(zv.w)};
                float ss = 0.f;
#pragma unroll
                for (int i = 0; i < 8; ++i) ss += v[i] * v[i];
                ss = red16(ss);
                const float rs = __builtin_amdgcn_rsqf(ss * (1.0f / 128.0f) + EPS);
#pragma unroll
                for (int i = 0; i < 8; ++i) v[i] = v[i] * rs * (i < 4 ? g0[i & 3] : g1[i & 3]) * z[i];
                u32x4 w; w.x = cvt_pk_bf16(v[0], v[1]); w.y = cvt_pk_bf16(v[2], v[3]); w.z = cvt_pk_bf16(v[4], v[5]); w.w = cvt_pk_bf16(v[6], v[7]);
                *(u32x4*)(P1 + (size_t)(rb + q) * N1 + 1536 + 8 * lane) = w; }
        }
    }
    xcd_barrier(bar);

    {
        pg8::SchedP5 S{(const char*)XN, (const char*)WGT, (const char*)P1, (const char*)WUPT, G, (int)blockIdx.x};
        pg8::Epi5 E{a.b_gate, GSC, GY, MG};
        pg8::gemm_phase<pg8::Epi5, pg8::SchedP5>(lds, S, E);
    }
    xcd_barrier(bar);

    {
        pg8::SchedPlain S{(const char*)MG, (const char*)WOT, 16, 128, 4, G, (int)blockIdx.x};
        pg8::Epi6 E{a.x, a.out};
        pg8::gemm_phase<pg8::Epi6, pg8::SchedPlain>(lds, S, E);
    }
}

extern "C" void kernel_launch(void* const* d_in, const int* in_sizes, int n_in, void* d_out, int out_size, void* d_ws, size_t ws_size, hipStream_t stream) {
    static int grid = 0;
    if (grid == 0) {
        if (n_in != 13 || out_size != M * DM || ws_size < WS_END) { fprintf(stderr, "kernel_launch: unexpected problem (n_in %d out %d ws %zu)\n", n_in, out_size, ws_size); grid = -1; return; }
        int dev = 0, cus = 0, per_cu = 0;
        (void)hipGetDevice(&dev); (void)hipDeviceGetAttribute(&cus, hipDeviceAttributeMultiprocessorCount, dev);
        (void)hipFuncSetAttribute((const void*)fwd, hipFuncAttributeMaxDynamicSharedMemorySize, LDS_BYTES);
        (void)hipOccupancyMaxActiveBlocksPerMultiprocessor(&per_cu, (const void*)fwd, NWAVES * 64, LDS_BYTES);
        if (per_cu < 1) fprintf(stderr, "kernel_launch: occupancy query says %d blocks per CU\n", per_cu);
        grid = cus;
    }
    if (grid < 0) return;
    (void)hipMemsetAsync((unsigned char*)d_ws + WS_BAR, 0, XCD_BAR_WORDS * 4, stream);
    Args a{};
    a.x = (const float*)d_in[0]; a.norm_gain = (const float*)d_in[1]; a.w_in = (const float*)d_in[2]; a.b_gate = (const float*)d_in[3]; a.conv_w = (const float*)d_in[4];
    a.a_log = (const float*)d_in[5]; a.dt_bias = (const float*)d_in[6]; a.dn_out_gain = (const float*)d_in[7]; a.sb_q_gain = (const float*)d_in[8]; a.sb_k_gain = (const float*)d_in[9];
    a.w_up_a = (const float*)d_in[10]; a.w_up_b = (const float*)d_in[11]; a.w_out = (const float*)d_in[12];
    a.out = (float*)d_out; a.ws = (unsigned char*)d_ws;
    void* args[] = {&a};
    hipError_t e = hipLaunchCooperativeKernel((const void*)fwd, dim3(grid), dim3(NWAVES * 64), args, LDS_BYTES, stream);
    if (e != hipSuccess) fprintf(stderr, "kernel_launch: cooperative launch failed: %s (grid %d)\n", hipGetErrorString(e), grid);
}
```

```cpp
#include <hip/hip_runtime.h>
#include <hip/hip_cooperative_groups.h>
#include <cstdio>
#include <cstdint>
namespace cg = cooperative_groups;

#define LAS __attribute__((address_space(3)))
typedef unsigned short bf16_t;
typedef short bf16x8 __attribute__((ext_vector_type(8)));
typedef float f32x4 __attribute__((ext_vector_type(4)));
typedef unsigned u32x4 __attribute__((ext_vector_type(4)));
typedef unsigned u32x2 __attribute__((ext_vector_type(2)));
typedef __bf16 bf16x2_t __attribute__((ext_vector_type(2)));

constexpr int M = 32768, DM = 1024, SEQ = 2048;
constexpr int N1 = 4096;
constexpr int PROJ = 6152;
constexpr float EPS = 1e-6f;
constexpr float QSCALE = 0.125f * 1.4426950408889634f;
constexpr int NWAVES = 8;
constexpr size_t MiB = (size_t)1 << 20;
constexpr size_t WS_CTL = 0, WS_W1T = 1 * MiB, WS_WGT = 9 * MiB, WS_WUPT = 13 * MiB, WS_WOT = 15 * MiB, WS_BG = 17 * MiB, WS_XN = 18 * MiB, WS_P1 = 82 * MiB,
                 WS_QKVA = 338 * MiB, WS_ORAW = 434 * MiB, WS_UF = 466 * MiB, WS_END = 498 * MiB;
constexpr size_t WS_GE = 4096;
constexpr size_t WS_BAR = 65536;
constexpr size_t WS_MG = WS_QKVA;
constexpr size_t WS_GSC = WS_ORAW;
constexpr size_t OUT_REC = 0, OUT_GY = 64 * MiB;
constexpr int REC_BYTES = 57344;
constexpr int LDS_BYTES = 147456 + 256;

typedef float f32x2_t __attribute__((ext_vector_type(2)));
__device__ __forceinline__ unsigned cvt_pk_bf16(float lo, float hi) { unsigned r; asm volatile("s_nop 1\n\tv_cvt_pk_bf16_f32 %0, %1, %2\n\ts_nop 1" : "=v"(r) : "v"(lo), "v"(hi)); return r; }
__device__ __forceinline__ unsigned cvt_pk_safe(float lo, float hi) { unsigned r; asm volatile("s_nop 7\n\ts_nop 7\n\ts_nop 3\n\tv_cvt_pk_bf16_f32 %0, %1, %2\n\ts_nop 1" : "=v"(r) : "v"(lo), "v"(hi)); return r; }
__device__ __forceinline__ float bflo(unsigned w) { return __uint_as_float(w << 16); }
__device__ __forceinline__ float bfhi(unsigned w) { return __uint_as_float(w & 0xffff0000u); }
__device__ __forceinline__ float sigmoidf_(float v) { return __builtin_amdgcn_rcpf(1.0f + __expf(-v)); }
__device__ __forceinline__ float wave_sum(float v) {
#pragma unroll
    for (int o = 1; o < 64; o <<= 1) v += __shfl_xor(v, o);
    return v;
}
#define DPP_ADD(v, CTRL) v += __builtin_bit_cast(float, __builtin_amdgcn_update_dpp(0, __builtin_bit_cast(int, v), CTRL, 0xF, 0xF, true))
__device__ __forceinline__ float red16(float v) {
    DPP_ADD(v, 0xB1); DPP_ADD(v, 0x4E); DPP_ADD(v, 0x141); DPP_ADD(v, 0x140);
    return v;
}

namespace pg8 {
constexpr int BM = 256, BK = 64, HALF = 128, HTB = HALF * BK * 2, NXCD = 8, WGM = 8;
constexpr int PITCH = 2048;
__device__ __forceinline__ int lds_byte(int r, int c) { const int st = (r >> 4) * 2 + (c >> 5), rr = r & 15, cc = c & 31, ob = rr * 64 + cc * 2; return st * 1024 + (ob ^ (((ob >> 9) & 1) << 5)); }
__device__ __forceinline__ void stage_rc(int b, int& R, int& C) { const int st = b / 1024, sb = b % 1024, swz = sb ^ (((sb >> 9) & 1) << 5); R = (st >> 1) * 16 + swz / 64; C = (st & 1) * 32 + (swz % 64) / 2; }
__device__ __forceinline__ int perm32(int rho) { const int n = rho >> 4, i = rho & 15; return 8 * (i >> 2) + 4 * n + (i & 3); }

struct Unit { const char* A; const char* B; int nt, pm, pn, sub, ap; };

__device__ __forceinline__ void tile_of(int L, int nM, int nN, int& pm, int& pn) {
    const int nwg = nM * nN; int wgid = L;
    { const int q = nwg / NXCD, r = nwg % NXCD, xcd = wgid % NXCD, off = wgid / NXCD; wgid = (xcd < r ? xcd * (q + 1) : r * (q + 1) + (xcd - r) * q) + off; }
    const int nig = WGM * nN, gid = wgid / nig, fm = gid * WGM, gsz = (nM - fm) < WGM ? (nM - fm) : WGM;
    pm = fm + ((wgid % nig) % gsz); pn = (wgid % nig) / gsz;
}
struct SchedPlain {
    const char* A; const char* B; int nt, nM, nN, G, c;
    __device__ __forceinline__ bool next(int i, Unit& u) const {
        const long L = (long)i * G + c; if (L >= (long)nM * nN) return false;
        tile_of((int)L, nM, nN, u.pm, u.pn);
        u.A = A + (size_t)u.pm * BM * PITCH; u.B = B + (size_t)u.pn * BM * PITCH; u.nt = nt; u.sub = 0; u.ap = 0; return true;
    }
};
struct SchedP5 {
    const char* XN; const char* WG; const char* P1; const char* WUP; int G, c;
    __device__ __forceinline__ bool next(int i, Unit& u) const {
        const int ti = i >> 2, sub = i & 3; const long L = (long)ti * G + c; if (L >= 128 * 4) return false;
        tile_of((int)L, 128, 4, u.pm, u.pn); u.sub = sub;
        if (sub == 0)      { u.A = XN + (size_t)u.pm * BM * PITCH;            u.B = WG + (size_t)(u.pn * BM) * PITCH;         u.nt = 16; u.ap = 0; }
        else if (sub == 1) { u.A = P1 + (size_t)u.pm * BM * 8192 + 1536 * 2; u.B = WUP + (size_t)(u.pn * BM) * PITCH;        u.nt = 8;  u.ap = 1; }
        else if (sub == 2) { u.A = XN + (size_t)u.pm * BM * PITCH;            u.B = WG + (size_t)(1024 + u.pn * BM) * PITCH;  u.nt = 16; u.ap = 0; }
        else               { u.A = P1 + (size_t)u.pm * BM * 8192 + 2048 * 2; u.B = WUP + (size_t)(u.pn * BM) * PITCH + 1024; u.nt = 8;  u.ap = 1; }
        return true;
    }
};

template <class Epi, class Sched>
__device__ __forceinline__ void gemm_phase(LAS unsigned char* lds, const Sched& S, const Epi& E) {
    int tid = threadIdx.x; asm volatile("" : "+v"(tid));
    const int wid = __builtin_amdgcn_readfirstlane(tid >> 6), lane = tid & 63, wr = wid >> 2, wc = wid & 3, fr = lane & 15, fq = lane >> 4;
    unsigned vRC, voffB;
    { int R, C; stage_rc(tid * 16, R, C); const int Rb = (R & ~31) + perm32(R & 31); vRC = (unsigned)(R * PITCH + C * 2); voffB = (unsigned)(Rb * PITCH + C * 2); }
#define PG8_VA(ap) ((ap) ? (((vRC >> 11) << 13) + (vRC & 2047u)) : vRC)
    const size_t kstep = (size_t)(BK * 2);
    const size_t hstep = (size_t)HALF * PITCH;
    const unsigned ldsw = (unsigned)wid * 1024u;
    const int aoff = lds_byte(wr * 64 + fr, fq * 8), boff = lds_byte(wc * 32 + fr, fq * 8);
#define PG8_SA(b, h) (((b) * 2 + (h)) * HTB)
#define PG8_SB(b, h) ((4 + (b) * 2 + (h)) * HTB)
#define PG8_STAGE(bufoff, gbase, voff, d64) do { _Pragma("unroll") for (int _i = 0; _i < 2; ++_i) \
        __builtin_amdgcn_global_load_lds((const unsigned*)((const char*)(gbase) + (size_t)_i * (d64) + (voff)), (LAS unsigned*)(lds + (bufoff) + ldsw + _i * 8192), 16, 0, 0); } while (0)
#define PG8_STAGEB(bufoff, gbase) PG8_STAGE(bufoff, gbase, voffB, (size_t)64 * PITCH)
#define PG8_LDA(dst, b, h) do { _Pragma("unroll") for (int m = 0; m < 4; ++m) _Pragma("unroll") for (int k = 0; k < 2; ++k) dst[m][k] = *(const LAS bf16x8*)(lds + PG8_SA(b, h) + aoff + m * 2048 + k * 1024); } while (0)
#define PG8_LDB(dst, b, h) do { _Pragma("unroll") for (int n = 0; n < 2; ++n) _Pragma("unroll") for (int k = 0; k < 2; ++k) dst[n][k] = *(const LAS bf16x8*)(lds + PG8_SB(b, h) + boff + n * 2048 + k * 1024); } while (0)
#define PG8_MMA(ai, bj, At, Bt) do { __builtin_amdgcn_s_setprio(1); _Pragma("unroll") for (int m = 0; m < 4; ++m) _Pragma("unroll") for (int n = 0; n < 2; ++n) _Pragma("unroll") for (int k = 0; k < 2; ++k) \
        acc[ai][bj][m][n] = __builtin_amdgcn_mfma_f32_16x16x32_bf16(Bt[n][k], At[m][k], acc[ai][bj][m][n], 0, 0, 0); __builtin_amdgcn_s_setprio(0); } while (0)
#define PG8_WAIT_V(n) asm volatile("s_waitcnt vmcnt(" #n ")" ::: "memory")
#define PG8_WAIT_L(n) asm volatile("s_waitcnt lgkmcnt(" #n ")" ::: "memory")
#define PG8_BAR __builtin_amdgcn_s_barrier()
#define PG8_SCHED __builtin_amdgcn_sched_barrier(0)
    Unit cur, nxt; int ui = 0;
    if (!S.next(0, cur)) return;
    f32x4 acc[2][2][4][2];
#pragma unroll
    for (int a = 0; a < 2; ++a)
#pragma unroll
        for (int b = 0; b < 2; ++b)
#pragma unroll
            for (int m = 0; m < 4; ++m)
#pragma unroll
                for (int n = 0; n < 2; ++n) acc[a][b][m][n] = (f32x4){0.f, 0.f, 0.f, 0.f};
    bf16x8 At[4][2], B0[2][2], B1[2][2];
    const char* cA = cur.A; const char* cB = cur.B;
    unsigned voffA = PG8_VA(cur.ap);
    size_t hA = cur.ap ? (size_t)HALF * 8192 : hstep;
    PG8_STAGEB(PG8_SB(0, 0), cB); PG8_STAGEB(PG8_SB(0, 1), cB + hstep); PG8_STAGE(PG8_SA(0, 0), cA, voffA, hA >> 1); PG8_STAGE(PG8_SA(0, 1), cA + hA, voffA, hA >> 1);
    if (wr == 1) PG8_BAR;
    PG8_WAIT_V(2); PG8_BAR;
    PG8_STAGEB(PG8_SB(1, 0), cB + kstep); PG8_STAGE(PG8_SA(1, 0), cA + kstep, voffA, hA >> 1); PG8_STAGEB(PG8_SB(1, 1), cB + hstep + kstep);
    PG8_WAIT_V(6); PG8_BAR;
    for (;;) {
        const bool has_next = S.next(ui + 1, nxt);
        const char* nA = has_next ? nxt.A : cA; const char* nB = has_next ? nxt.B : cB;
        const int nap = has_next ? nxt.ap : cur.ap;
        const unsigned voffN = PG8_VA(nap);
        const size_t hN = nap ? (size_t)HALF * 8192 : hstep;
        const int nt = cur.nt;
        for (int t = 0; t < nt; t += 2) {
            const bool last = (t == nt - 2);
            const char* a1 = cA + (size_t)(t + 1) * kstep;
            const char* a2 = last ? nA : cA + (size_t)(t + 2) * kstep; const char* b2 = last ? nB : cB + (size_t)(t + 2) * kstep;
            const char* a3 = a2 + kstep; const char* b3 = b2 + kstep;
            const unsigned voff2 = last ? voffN : voffA;
            const size_t h2 = last ? hN : hA;
            PG8_LDB(B0, 0, 0); PG8_LDB(B1, 0, 1); PG8_SCHED; PG8_LDA(At, 0, 0); PG8_STAGE(PG8_SA(1, 1), a1 + hA, voffA, hA >> 1);
            PG8_WAIT_V(8); PG8_WAIT_L(0); PG8_BAR; PG8_MMA(0, 0, At, B0); PG8_MMA(0, 1, At, B1); PG8_BAR; PG8_SCHED;
            PG8_LDA(At, 0, 1); PG8_STAGEB(PG8_SB(0, 0), b2); PG8_STAGEB(PG8_SB(0, 1), b2 + hstep); PG8_STAGE(PG8_SA(0, 0), a2, voff2, h2 >> 1);
            PG8_WAIT_V(8); PG8_WAIT_L(0); PG8_BAR; PG8_MMA(1, 0, At, B0); PG8_MMA(1, 1, At, B1); PG8_BAR; PG8_SCHED;
            PG8_LDB(B0, 1, 0); PG8_LDB(B1, 1, 1); PG8_SCHED; PG8_LDA(At, 1, 0); PG8_STAGE(PG8_SA(0, 1), a2 + h2, voff2, h2 >> 1);
            PG8_WAIT_V(8); PG8_WAIT_L(0); PG8_BAR; PG8_MMA(0, 0, At, B0); PG8_MMA(0, 1, At, B1); PG8_BAR; PG8_SCHED;
            PG8_LDA(At, 1, 1); PG8_STAGEB(PG8_SB(1, 0), b3); PG8_STAGEB(PG8_SB(1, 1), b3 + hstep); PG8_STAGE(PG8_SA(1, 0), a3, voff2, h2 >> 1);
            PG8_WAIT_V(8); PG8_WAIT_L(0); PG8_BAR; PG8_MMA(1, 0, At, B0); PG8_MMA(1, 1, At, B1); PG8_BAR; PG8_SCHED;
        }
        if (wr == 0) PG8_BAR;
        E(acc, cur, wr, wc, fr, fq);
        if (!has_next) break;
#pragma unroll
        for (int a = 0; a < 2; ++a)
#pragma unroll
            for (int b = 0; b < 2; ++b)
#pragma unroll
                for (int m = 0; m < 4; ++m)
#pragma unroll
                    for (int n = 0; n < 2; ++n) acc[a][b][m][n] = (f32x4){0.f, 0.f, 0.f, 0.f};
        cur = nxt; cA = nA; cB = nB; ++ui; voffA = voffN; hA = hN;
        if (wr == 1) PG8_BAR;
    }
    PG8_WAIT_V(0);
    PG8_BAR;
#undef PG8_SA
#undef PG8_SB
#undef PG8_STAGE
#undef PG8_STAGEB
#undef PG8_VA
#undef PG8_LDA
#undef PG8_LDB
#undef PG8_MMA
#undef PG8_WAIT_V
#undef PG8_WAIT_L
#undef PG8_BAR
#undef PG8_SCHED
}

struct Epi1 {
    bf16_t* P1; const float* qg; const float* kg;
    __device__ __forceinline__ void operator()(const f32x4 (&acc)[2][2][4][2], const Unit& u, int wr, int wc, int fr, int fq) const {
        const int pn = u.pn;
        const int kind = (pn < 6) ? 0 : (pn < 8) ? 1 : (pn < 10) ? 2 : (pn < 12) ? 3 : (pn < 14) ? 4 : 1;
        const int col0 = pn * BM + wc * 64 + 8 * fq;
        const size_t row0 = (size_t)u.pm * BM + wr * 64 + fr;
        f32x4 gn[2][2];
#pragma unroll
        for (int bj = 0; bj < 2; ++bj)
#pragma unroll
            for (int n = 0; n < 2; ++n) gn[bj][n] = (f32x4){1.f, 1.f, 1.f, 1.f};
        if (kind >= 2) { const float* g = (kind == 2) ? qg : kg; const float sc = (kind == 2) ? QSCALE : 1.0f;
#pragma unroll
            for (int bj = 0; bj < 2; ++bj)
#pragma unroll
                for (int n = 0; n < 2; ++n) gn[bj][n] = *(const f32x4*)(g + 32 * bj + 8 * fq + 4 * n) * sc; }
        if (kind == 4) {
            const int hh = 4 * (pn - 12) + wc; const int tok0 = u.pm * BM + wr * 64 + fr; const int bb = tok0 >> 11;
            bf16_t* vb = P1 + (size_t)bb * SEQ * N1 + 3072 + 64 * hh;
#pragma unroll
            for (int ai = 0; ai < 2; ++ai)
#pragma unroll
                for (int m = 0; m < 4; ++m) { const int sq = (tok0 + ai * HALF + m * 16) & (SEQ - 1); const int cs = (sq & 48) | ((sq & 4) << 1) | ((sq & 8) >> 1) | (sq & 3);
                    unsigned off = (unsigned)((sq >> 6) * N1 + cs + (8 * fq) * 32 * N1); asm volatile("" : "+v"(off));
#pragma unroll
                    for (int bj = 0; bj < 2; ++bj)
#pragma unroll
                        for (int n = 0; n < 2; ++n) { const f32x4 x = acc[ai][bj][m][n]; const unsigned w0 = cvt_pk_bf16(x[0], x[1]), w1 = cvt_pk_bf16(x[2], x[3]); bf16_t* bp = vb + off + (unsigned)((32 * bj + 4 * n) * 32 * N1);
                            bp[0 * 32 * N1] = (bf16_t)(w0 & 0xffffu); bp[1 * 32 * N1] = (bf16_t)(w0 >> 16); bp[2 * 32 * N1] = (bf16_t)(w1 & 0xffffu); bp[3 * 32 * N1] = (bf16_t)(w1 >> 16); }
                    asm volatile("" ::: "memory"); }
            return;
        }
#pragma unroll
        for (int ai = 0; ai < 2; ++ai)
#pragma unroll
            for (int m = 0; m < 4; ++m) {
                bf16_t* rowp = P1 + (row0 + ai * HALF + m * 16) * N1 + col0;
                float rs = 1.f;
                if (kind >= 2) { float ss = 0.f;
#pragma unroll
                    for (int bj = 0; bj < 2; ++bj)
#pragma unroll
                        for (int n = 0; n < 2; ++n) { const f32x4 x = acc[ai][bj][m][n]; ss += (x[0] * x[0] + x[1] * x[1]) + (x[2] * x[2] + x[3] * x[3]); }
                    ss += __shfl_xor(ss, 16); ss += __shfl_xor(ss, 32);
                    rs = __builtin_amdgcn_rsqf(ss * (1.0f / 64.0f) + EPS); }
#pragma unroll
                for (int bj = 0; bj < 2; ++bj) { f32x4 v0 = acc[ai][bj][m][0], v1 = acc[ai][bj][m][1];
                    if (kind == 1) {
#pragma unroll
                        for (int j = 0; j < 4; ++j) { v0[j] = v0[j] * sigmoidf_(v0[j]); v1[j] = v1[j] * sigmoidf_(v1[j]); } }
                    else if (kind >= 2) { v0 = v0 * rs * gn[bj][0]; v1 = v1 * rs * gn[bj][1]; }
                    u32x4 w; w.x = cvt_pk_bf16(v0[0], v0[1]); w.y = cvt_pk_bf16(v0[2], v0[3]); w.z = cvt_pk_bf16(v1[0], v1[1]); w.w = cvt_pk_bf16(v1[2], v1[3]);
                    *(u32x4*)(rowp + 32 * bj) = w; }
                asm volatile("" ::: "memory");
            }
    }
};
struct Epi5 {
    const float* bgate; bf16_t* gsc; bf16_t* gy; bf16_t* MG;
    __device__ __forceinline__ void operator()(const f32x4 (&acc)[2][2][4][2], const Unit& u, int wr, int wc, int fr, int fq) const {
        const int sub = u.sub;
        const int lc0 = wc * 32 + 8 * fq, lr0 = wr * 64 + fr;
        int toff = lr0 * 256 + lc0; asm volatile("" : "+v"(toff));
        if (sub == 0 || sub == 2) {
            const float* bp = bgate + (sub == 2 ? 1024 : 0) + u.pn * BM + lc0;
            f32x4 bb[2][2];
#pragma unroll
            for (int bj = 0; bj < 2; ++bj) { bb[bj][0] = *(const f32x4*)(bp + bj * HALF); bb[bj][1] = *(const f32x4*)(bp + bj * HALF + 4); }
#pragma unroll
            for (int ai = 0; ai < 2; ++ai)
#pragma unroll
                for (int m = 0; m < 4; ++m) {
#pragma unroll
                    for (int bj = 0; bj < 2; ++bj) { const f32x4 a0 = acc[ai][bj][m][0] + bb[bj][0], a1 = acc[ai][bj][m][1] + bb[bj][1];
                        u32x4 w; w.x = cvt_pk_bf16(sigmoidf_(a0[0]), sigmoidf_(a0[1])); w.y = cvt_pk_bf16(sigmoidf_(a0[2]), sigmoidf_(a0[3]));
                        w.z = cvt_pk_bf16(sigmoidf_(a1[0]), sigmoidf_(a1[1])); w.w = cvt_pk_bf16(sigmoidf_(a1[2]), sigmoidf_(a1[3]));
                        *(u32x4*)(gsc + toff + (ai * HALF + m * 16) * 256 + bj * HALF) = w; }
                    asm volatile("" ::: "memory"); }
        } else if (sub == 1) {
#pragma unroll
            for (int ai = 0; ai < 2; ++ai)
#pragma unroll
                for (int m = 0; m < 4; ++m) {
#pragma unroll
                    for (int bj = 0; bj < 2; ++bj) { const int o = toff + (ai * HALF + m * 16) * 256 + bj * HALF; const f32x4 a0 = acc[ai][bj][m][0], a1 = acc[ai][bj][m][1];
                        const u32x4 g = *(const u32x4*)(gsc + o); u32x4 w;
                        w.x = cvt_pk_bf16(bflo(g.x) * a0[0], bfhi(g.x) * a0[1]); w.y = cvt_pk_bf16(bflo(g.y) * a0[2], bfhi(g.y) * a0[3]);
                        w.z = cvt_pk_bf16(bflo(g.z) * a1[0], bfhi(g.z) * a1[1]); w.w = cvt_pk_bf16(bflo(g.w) * a1[2], bfhi(g.w) * a1[3]);
                        *(u32x4*)(gy + o) = w; }
                    asm volatile("" ::: "memory"); }
        } else {
            bf16_t* mg = MG + ((size_t)u.pm * BM + lr0) * DM + u.pn * BM + lc0;
#pragma unroll
            for (int ai = 0; ai < 2; ++ai)
#pragma unroll
                for (int m = 0; m < 4; ++m) {
#pragma unroll
                    for (int bj = 0; bj < 2; ++bj) { const int o = toff + (ai * HALF + m * 16) * 256 + bj * HALF; const f32x4 a0 = acc[ai][bj][m][0], a1 = acc[ai][bj][m][1];
                        const u32x4 g = *(const u32x4*)(gsc + o); const u32x4 y = *(const u32x4*)(gy + o); u32x4 w;
                        w.x = cvt_pk_bf16(bflo(y.x) + bflo(g.x) * a0[0], bfhi(y.x) + bfhi(g.x) * a0[1]); w.y = cvt_pk_bf16(bflo(y.y) + bflo(g.y) * a0[2], bfhi(y.y) + bfhi(g.y) * a0[3]);
                        w.z = cvt_pk_bf16(bflo(y.z) + bflo(g.z) * a1[0], bfhi(y.z) + bfhi(g.z) * a1[1]); w.w = cvt_pk_bf16(bflo(y.w) + bflo(g.w) * a1[2], bfhi(y.w) + bfhi(g.w) * a1[3]);
                        *(u32x4*)(mg + (ai * HALF + m * 16) * DM + bj * HALF) = w; }
                    asm volatile("" ::: "memory"); }
        }
    }
};
struct Epi6 {
    const float* x; float* out;
    __device__ __forceinline__ void operator()(const f32x4 (&acc)[2][2][4][2], const Unit& u, int wr, int wc, int fr, int fq) const {
        const int lc0 = u.pn * BM + wc * 32 + 8 * fq; const size_t row0 = (size_t)u.pm * BM + wr * 64 + fr;
#pragma unroll
        for (int ai = 0; ai < 2; ++ai)
#pragma unroll
            for (int m = 0; m < 4; ++m) { const size_t off = (row0 + ai * HALF + m * 16) * DM + lc0;
#pragma unroll
                for (int bj = 0; bj < 2; ++bj) { const f32x4 x0 = __builtin_nontemporal_load((const f32x4*)(x + off + bj * HALF)), x1 = __builtin_nontemporal_load((const f32x4*)(x + off + bj * HALF + 4));
                    __builtin_nontemporal_store(x0 + acc[ai][bj][m][0], (f32x4*)(out + off + bj * HALF)); __builtin_nontemporal_store(x1 + acc[ai][bj][m][1], (f32x4*)(out + off + bj * HALF + 4)); }
                asm volatile("" ::: "memory"); }
    }
};
}

#define XB_TMO      128
#define XB_XCNT(j)  (256  + 64 * (j))
#define XB_XSUB(j)  (1280 + 64 * (j))
#define XB_XGEN(j)  (2304 + 64 * (j))
#define XB_TOP      3328
#define XB_TOPGEN   3392
#define XCD_BAR_WORDS 3456
#define XB_SPIN_CAP (1u << 18)

__device__ __forceinline__ unsigned xb_ld(unsigned* p)              { return __hip_atomic_load(p, __ATOMIC_RELAXED, __HIP_MEMORY_SCOPE_AGENT); }
__device__ __forceinline__ unsigned xb_add(unsigned* p, unsigned v) { return __hip_atomic_fetch_add(p, v, __ATOMIC_RELAXED, __HIP_MEMORY_SCOPE_AGENT); }
__device__ __forceinline__ unsigned xb_xcc_id() { return (unsigned)__builtin_amdgcn_s_getreg((3 << 11) | 20) & 0xFu; }
#define XB_SPIN(cond, bar) do { unsigned _sp = 0; while (cond) { __builtin_amdgcn_s_sleep(1); \
    if ((++_sp & 255u) == 0u) { if (xb_ld(&(bar)[XB_TMO])) break; if (_sp > XB_SPIN_CAP) { atomicAdd(&(bar)[XB_TMO], 1u); break; } } } } while (0)

struct XcdBarrier {
    unsigned* bar; unsigned x;
    volatile LAS unsigned* st;
};

__device__ __forceinline__ XcdBarrier xcd_barrier_post(unsigned* bar, volatile LAS unsigned* st) {
    XcdBarrier b; b.bar = bar; b.x = xb_xcc_id(); b.st = st;
    if (threadIdx.x == 0) (void)xb_add(&bar[XB_XCNT(b.x)], 1u);
    return b;
}
__device__ __forceinline__ void xcd_barrier_complete(unsigned* bar, unsigned x, unsigned& nloc, unsigned& nx) {
    const unsigned G = gridDim.x * gridDim.y * gridDim.z;
    unsigned sum, cnt, mine, sp = 0u;
    for (;;) {
        sum = 0u; cnt = 0u; mine = 0u;
#pragma unroll
        for (unsigned j = 0; j < 16; ++j) { const unsigned c = xb_ld(&bar[XB_XCNT(j)]); sum += c; cnt += (c > 0u) ? 1u : 0u; mine = (j == x) ? c : mine; }
        if (sum == G) break;
        __builtin_amdgcn_s_sleep(1);
        if ((++sp & 255u) == 0u) { if (xb_ld(&bar[XB_TMO])) break; if (sp > XB_SPIN_CAP) { atomicAdd(&bar[XB_TMO], 1u); break; } }
    }
    nloc = mine > 0u ? mine : 1u; nx = cnt > 0u ? cnt : 1u;
}

__device__ __forceinline__ void xcd_barrier(const XcdBarrier& b) {
    asm volatile("s_waitcnt vmcnt(0)" ::: "memory");
    __syncthreads();
    if (threadIdx.x == 0) {
        unsigned* bar = b.bar;
        __builtin_amdgcn_s_waitcnt(0);
        unsigned nloc = b.st[0], nx = b.st[1];
        if (nloc == 0u) { xcd_barrier_complete(bar, b.x, nloc, nx); b.st[0] = nloc; b.st[1] = nx; }
        const unsigned old = xb_add(&bar[XB_XSUB(b.x)], 1u);
        const unsigned gen = old / nloc;
        if (old + 1u == (gen + 1u) * nloc) {
            __builtin_amdgcn_fence(__ATOMIC_RELEASE, "agent");
            asm volatile("s_waitcnt vmcnt(0)" ::: "memory");
            const unsigned og = xb_add(&bar[XB_TOP], 1u);
            const unsigned tg = og / nx;
            if (og + 1u == (tg + 1u) * nx) xb_add(&bar[XB_TOPGEN], 1u);
            else XB_SPIN(xb_ld(&bar[XB_TOPGEN]) == tg, bar);
            __builtin_amdgcn_fence(__ATOMIC_ACQUIRE, "agent");
            xb_add(&bar[XB_XGEN(b.x)], 1u);
            asm volatile("s_waitcnt vmcnt(0)" ::: "memory");
        } else {
            XB_SPIN(xb_ld(&bar[XB_XGEN(b.x)]) == gen, bar);
            __builtin_amdgcn_fence(__ATOMIC_ACQUIRE, "agent");
            asm volatile("s_waitcnt vmcnt(0)" ::: "memory");
        }
    }
    __syncthreads();
}

struct Args {
    const float *x, *norm_gain, *w_in, *b_gate, *conv_w, *a_log, *dt_bias, *dn_out_gain, *sb_q_gain, *sb_k_gain, *w_up_a, *w_up_b, *w_out;
    float* out; unsigned char* ws; int never; int pad;
};

__device__ __forceinline__ void p0_transpose_item(const float* W, int ldw, int src_col0, int k0, bf16_t* WT, int dst_row0, int dst_k0, LAS float* scr, int lane) {
#pragma unroll 8
    for (int i = 0; i < 32; ++i) { const int kk = 2 * i + (lane >> 5); scr[kk * 33 + (lane & 31)] = W[(size_t)(k0 + kk) * ldw + src_col0 + (lane & 31)]; }
    asm volatile("s_waitcnt lgkmcnt(0)" ::: "memory");
    const int c = lane & 7;
#pragma unroll
    for (int j = 0; j < 4; ++j) { const int n = (lane >> 3) + 8 * j; const LAS float* s = scr + (8 * c) * 33 + n;
        u32x4 o; o.x = cvt_pk_bf16(s[0 * 33], s[1 * 33]); o.y = cvt_pk_bf16(s[2 * 33], s[3 * 33]); o.z = cvt_pk_bf16(s[4 * 33], s[5 * 33]); o.w = cvt_pk_bf16(s[6 * 33], s[7 * 33]);
        *(u32x4*)(WT + (size_t)(dst_row0 + n) * 1024 + dst_k0 + 8 * c) = o; }
    asm volatile("s_waitcnt lgkmcnt(0)" ::: "memory");
}


#define MFMA16(a, b, c) __builtin_amdgcn_mfma_f32_16x16x32_bf16((a), (b), (c), 0, 0, 0)
__device__ __forceinline__ bf16x8 pack8(const f32x4 lo, const f32x4 hi) {
    u32x4 w;
    asm volatile("s_nop 7\n\ts_nop 7\n\ts_nop 3\n\tv_cvt_pk_bf16_f32 %0, %4, %5\n\tv_cvt_pk_bf16_f32 %1, %6, %7\n\tv_cvt_pk_bf16_f32 %2, %8, %9\n\tv_cvt_pk_bf16_f32 %3, %10, %11\n\ts_nop 1"
                 : "=&v"(w.x), "=&v"(w.y), "=&v"(w.z), "=&v"(w.w) : "v"(lo[0]), "v"(lo[1]), "v"(lo[2]), "v"(lo[3]), "v"(hi[0]), "v"(hi[1]), "v"(hi[2]), "v"(hi[3]));
    return __builtin_bit_cast(bf16x8, w);
}
#define LDS_FENCE() asm volatile("s_waitcnt lgkmcnt(0)" ::: "memory")

__device__ __forceinline__ void dn_rows_load(const bf16_t* QKVA, size_t row0, int col0, int lane, u32x4 (&r)[8]) {
    const bf16_t* rp = QKVA + (row0 + lane) * 1536 + col0;
#pragma unroll
    for (int grp = 0; grp < 8; ++grp) r[grp] = *(const u32x4*)(rp + 8 * grp);
}
__device__ __forceinline__ void dn_rows_to_lds(const u32x4 (&r)[8], LAS bf16_t* XT, int lane) {
#pragma unroll
    for (int grp = 0; grp < 8; ++grp) { const u32x4 w = r[grp]; LAS bf16_t* d = XT + (8 * grp) * 72 + lane;
        d[0 * 72] = (bf16_t)(w.x & 0xffffu); d[1 * 72] = (bf16_t)(w.x >> 16); d[2 * 72] = (bf16_t)(w.y & 0xffffu); d[3 * 72] = (bf16_t)(w.y >> 16);
        d[4 * 72] = (bf16_t)(w.z & 0xffffu); d[5 * 72] = (bf16_t)(w.z >> 16); d[6 * 72] = (bf16_t)(w.w & 0xffffu); d[7 * 72] = (bf16_t)(w.w >> 16); }
}

__device__ __forceinline__ void dn_prep(int task, LAS unsigned char* L, const bf16_t* QKVA, const float* BG, unsigned char* REC, bf16_t* UF, float* GE, int lane) {
    const int n = task & 31, h = (task >> 5) & 3, b = task >> 7;
    const size_t row0 = (size_t)b * SEQ + n * 64;
    LAS bf16_t* Mm = (LAS bf16_t*)L; LAS bf16_t* TT = (LAS bf16_t*)L;
    LAS bf16_t* XT = (LAS bf16_t*)(L + 8192);
    LAS float* GC = (LAS float*)(L + 17408); LAS float* BT = GC + 64; LAS float* DSC = GC + 128; LAS float* EGC = GC + 192;
    const int fr = lane & 15, fq = lane >> 4;
    unsigned char* rec = REC + (size_t)task * REC_BYTES;
    const float g = __hip_atomic_load(BG + (row0 + lane) * 8 + 4 + h, __ATOMIC_RELAXED, __HIP_MEMORY_SCOPE_AGENT), beta = __hip_atomic_load(BG + (row0 + lane) * 8 + h, __ATOMIC_RELAXED, __HIP_MEMORY_SCOPE_AGENT);
    float gc = g;
#pragma unroll
    for (int o = 1; o < 64; o <<= 1) { const float v = __shfl_up(gc, o); if (lane >= o) gc += v; }
    const float gl = __shfl(gc, 63);
    const float egc = __expf(gc);
    GC[lane] = gc; BT[lane] = beta; DSC[lane] = __expf(gl - gc); EGC[lane] = egc;
    if (lane == 0) GE[task] = __expf(gl);
    LDS_FENCE();
    bf16x8 kf[4][4];
#pragma unroll
    for (int mt = 0; mt < 4; ++mt)
#pragma unroll
        for (int ks = 0; ks < 4; ++ks) { const bf16_t* rp = QKVA + (row0 + 16 * mt + fr) * 1536 + 128 * h + 32 * ks + 4 * fq + 512;
            const u32x2 kl = *(const u32x2*)(rp), kh = *(const u32x2*)(rp + 16);
            u32x4 kw; kw.x = kl.x; kw.y = kl.y; kw.z = kh.x; kw.w = kh.y; kf[mt][ks] = __builtin_bit_cast(bf16x8, kw); }
    u32x4 qnx[4];
#pragma unroll
    for (int ks = 0; ks < 4; ++ks) { const bf16_t* rp = QKVA + (row0 + fr) * 1536 + 128 * h + 32 * ks + 4 * fq; const u32x2 ql = *(const u32x2*)(rp), qh = *(const u32x2*)(rp + 16); qnx[ks].x = ql.x; qnx[ks].y = ql.y; qnx[ks].z = qh.x; qnx[ks].w = qh.y; }
#pragma unroll
    for (int nt = 0; nt < 4; ++nt) { const float gci = GC[16 * nt + fr], sc = EGC[16 * nt + fr]; const int ic = 16 * nt + fr;
        bf16x8 qf[4]; u32x4 qw[4];
#pragma unroll
        for (int ks = 0; ks < 4; ++ks) qw[ks] = qnx[ks];
        if (nt < 3) {
#pragma unroll
            for (int ks = 0; ks < 4; ++ks) { const bf16_t* rp = QKVA + (row0 + 16 * (nt + 1) + fr) * 1536 + 128 * h + 32 * ks + 4 * fq; const u32x2 ql = *(const u32x2*)(rp), qh = *(const u32x2*)(rp + 16); qnx[ks].x = ql.x; qnx[ks].y = ql.y; qnx[ks].z = qh.x; qnx[ks].w = qh.y; } }
#pragma unroll
        for (int ks = 0; ks < 4; ++ks) { const u32x4 w = qw[ks]; qf[ks] = __builtin_bit_cast(bf16x8, w); u32x4 o;
            o.x = cvt_pk_safe(bflo(w.x) * sc, bfhi(w.x) * sc); o.y = cvt_pk_safe(bflo(w.y) * sc, bfhi(w.y) * sc); o.z = cvt_pk_safe(bflo(w.z) * sc, bfhi(w.z) * sc); o.w = cvt_pk_safe(bflo(w.w) * sc, bfhi(w.w) * sc);
            *(u32x4*)(rec + 16384 + ((ks * 4 + nt) * 64 + lane) * 16) = o; }
#pragma unroll
        for (int ks2 = 0; ks2 < 2; ++ks2) { f32x4 d0 = {0.f, 0.f, 0.f, 0.f}, d1 = {0.f, 0.f, 0.f, 0.f};
#pragma unroll
            for (int ks = 0; ks < 4; ++ks) { d0 = MFMA16(kf[2 * ks2][ks], qf[ks], d0); d1 = MFMA16(kf[2 * ks2 + 1][ks], qf[ks], d1); }
            const f32x4 gj0 = *(const LAS f32x4*)(GC + 32 * ks2 + 4 * fq), gj1 = *(const LAS f32x4*)(GC + 32 * ks2 + 16 + 4 * fq);
#pragma unroll
            for (int r = 0; r < 4; ++r) { const int j0 = 32 * ks2 + 4 * fq + r;
                d0[r] = (j0 <= ic) ? d0[r] * __expf(gci - gj0[r]) : 0.f; d1[r] = (j0 + 16 <= ic) ? d1[r] * __expf(gci - gj1[r]) : 0.f; }
            *(bf16x8*)(rec + 49152 + ((ks2 * 4 + nt) * 64 + lane) * 16) = pack8(d0, d1); }
        __builtin_amdgcn_sched_barrier(0); }
#pragma unroll
    for (int mt = 0; mt < 4; ++mt)
#pragma unroll
        for (int nt = 0; nt <= mt; ++nt) { f32x4 d = {0.f, 0.f, 0.f, 0.f};
#pragma unroll
            for (int ks = 0; ks < 4; ++ks) d = MFMA16(kf[mt][ks], kf[nt][ks], d);
            const float gcj = GC[16 * nt + fr]; const f32x4 gi = *(const LAS f32x4*)(GC + 16 * mt + 4 * fq), bi = *(const LAS f32x4*)(BT + 16 * mt + 4 * fq);
#pragma unroll
            for (int r = 0; r < 4; r += 2) { const int i = 16 * mt + 4 * fq + r, j = 16 * nt + fr; const float v0 = (j < i) ? bi[r] * d[r] * __expf(gi[r] - gcj) : 0.f, v1 = (j < i + 1) ? bi[r + 1] * d[r + 1] * __expf(gi[r + 1] - gcj) : 0.f;
                const unsigned w = cvt_pk_safe(v0, v1); Mm[i * 64 + j] = (bf16_t)(w & 0xffffu); Mm[(i + 1) * 64 + j] = (bf16_t)(w >> 16); } }
    __builtin_amdgcn_sched_barrier(0);
    u32x4 xr[8];
    dn_rows_load(QKVA, row0, 512 + 128 * h, lane, xr);
    LDS_FENCE();
    float t[64];
#define INV_ROWS(I0) _Pragma("unroll") for (int i = (I0); i < (I0) + 16; ++i) { float acc = (lane == i) ? 1.f : 0.f; \
        _Pragma("unroll") for (int jj = 0; jj < (i + 7) / 8; ++jj) { const u32x4 mv = *(const LAS u32x4*)(Mm + i * 64 + 8 * jj); \
            if (8 * jj + 0 < i) acc -= bflo(mv.x) * t[8 * jj + 0]; if (8 * jj + 1 < i) acc -= bfhi(mv.x) * t[8 * jj + 1]; if (8 * jj + 2 < i) acc -= bflo(mv.y) * t[8 * jj + 2]; if (8 * jj + 3 < i) acc -= bfhi(mv.y) * t[8 * jj + 3]; \
            if (8 * jj + 4 < i) acc -= bflo(mv.z) * t[8 * jj + 4]; if (8 * jj + 5 < i) acc -= bfhi(mv.z) * t[8 * jj + 5]; if (8 * jj + 6 < i) acc -= bflo(mv.w) * t[8 * jj + 6]; if (8 * jj + 7 < i) acc -= bfhi(mv.w) * t[8 * jj + 7]; } \
        t[i] = acc; }
    INV_ROWS(0) INV_ROWS(16) INV_ROWS(32) INV_ROWS(48)
#undef INV_ROWS
    LDS_FENCE();
    { const float s1 = beta * egc;
#pragma unroll
      for (int i = 0; i < 64; i += 2) { const unsigned w1 = cvt_pk_bf16(t[i] * s1, t[i + 1] * s1); TT[i * 64 + lane] = (bf16_t)(w1 & 0xffffu); TT[(i + 1) * 64 + lane] = (bf16_t)(w1 >> 16); } }
#pragma unroll
    for (int hf = 0; hf < 2; ++hf) {
        LDS_FENCE();
        dn_rows_to_lds(xr, XT, lane);
        if (hf == 0) dn_rows_load(QKVA, row0, 512 + 128 * h + 64, lane, xr); else dn_rows_load(QKVA, row0, 1024 + 128 * h, lane, xr);
        LDS_FENCE();
#pragma unroll
        for (int ks2 = 0; ks2 < 2; ++ks2) { const f32x4 s0 = *(const LAS f32x4*)(DSC + 32 * ks2 + 4 * fq), s1 = *(const LAS f32x4*)(DSC + 32 * ks2 + 16 + 4 * fq);
#pragma unroll
            for (int m4 = 0; m4 < 4; ++m4) { const LAS bf16_t* p = XT + (16 * m4 + fr) * 72 + 32 * ks2 + 4 * fq;
                const u32x2 lo = *(const LAS u32x2*)p, hi = *(const LAS u32x2*)(p + 16); u32x4 o;
                o.x = cvt_pk_bf16(bflo(lo.x) * s0[0], bfhi(lo.x) * s0[1]); o.y = cvt_pk_bf16(bflo(lo.y) * s0[2], bfhi(lo.y) * s0[3]);
                o.z = cvt_pk_bf16(bflo(hi.x) * s1[0], bfhi(hi.x) * s1[1]); o.w = cvt_pk_bf16(bflo(hi.y) * s1[2], bfhi(hi.y) * s1[3]);
                *(u32x4*)(rec + 32768 + ((ks2 * 8 + 4 * hf + m4) * 64 + lane) * 16) = o; } }
#pragma unroll
        for (int nt = 0; nt < 4; ++nt) { bf16x8 tb[2];
#pragma unroll
            for (int ks2 = 0; ks2 < 2; ++ks2) tb[ks2] = *(const LAS bf16x8*)(TT + (16 * nt + fr) * 64 + 32 * ks2 + 8 * fq);
            f32x4 d[4];
#pragma unroll
            for (int m4 = 0; m4 < 4; ++m4) { d[m4] = (f32x4){0.f, 0.f, 0.f, 0.f};
#pragma unroll
                for (int ks2 = 0; ks2 < 2; ++ks2) d[m4] = MFMA16(*(const LAS bf16x8*)(XT + (16 * m4 + fr) * 72 + 32 * ks2 + 8 * fq), tb[ks2], d[m4]); }
#pragma unroll
            for (int kl = 0; kl < 2; ++kl) *(bf16x8*)(rec + (((2 * hf + kl) * 4 + nt) * 64 + lane) * 16) = pack8(-d[2 * kl], -d[2 * kl + 1]); }
    }
    LDS_FENCE();
    {
#pragma unroll
      for (int i = 0; i < 64; i += 2) { const unsigned w2 = cvt_pk_bf16(t[i] * beta, t[i + 1] * beta); TT[i * 64 + lane] = (bf16_t)(w2 & 0xffffu); TT[(i + 1) * 64 + lane] = (bf16_t)(w2 >> 16); } }
    bf16_t* uf = UF + (size_t)task * 8192;
#pragma unroll
    for (int hf = 0; hf < 2; ++hf) {
        LDS_FENCE();
        dn_rows_to_lds(xr, XT, lane);
        if (hf == 0) dn_rows_load(QKVA, row0, 1024 + 128 * h + 64, lane, xr);
        LDS_FENCE();
#pragma unroll
        for (int mt = 0; mt < 4; ++mt) { bf16x8 ta[2];
#pragma unroll
            for (int ks2 = 0; ks2 < 2; ++ks2) ta[ks2] = *(const LAS bf16x8*)(TT + (16 * mt + fr) * 64 + 32 * ks2 + 8 * fq);
#pragma unroll
            for (int n4 = 0; n4 < 4; ++n4) { f32x4 d = {0.f, 0.f, 0.f, 0.f};
#pragma unroll
                for (int ks2 = 0; ks2 < 2; ++ks2) d = MFMA16(ta[ks2], *(const LAS bf16x8*)(XT + (16 * n4 + fr) * 72 + 32 * ks2 + 8 * fq), d);
                u32x2 o; o.x = cvt_pk_safe(d[0], d[1]); o.y = cvt_pk_safe(d[2], d[3]); *(u32x2*)(uf + (((4 * hf + n4) * 4 + mt) * 64 + lane) * 4) = o; } }
    }
    LDS_FENCE();
}

#define SCAN_BAR() do { asm volatile("s_waitcnt lgkmcnt(0)" ::: "memory"); __builtin_amdgcn_s_barrier(); asm volatile("" ::: "memory"); } while (0)
__device__ __forceinline__ void dn_scan_wg(int unit, LAS unsigned char* lds, const unsigned char* REC, const bf16_t* UF, const float* GE, bf16_t* ORAW, int tid, int wave, int lane) {
    const int bh = unit, b = bh >> 2, h = bh & 3;
    const int fr = lane & 15, fq = lane >> 4;
    constexpr int IMG = REC_BYTES + 16384;
    if (wave >= 4) {
        const int lt = tid - 256; const unsigned char* rbase = REC + (size_t)(bh * 32) * REC_BYTES + lt * 16; const unsigned char* ubase = (const unsigned char*)UF + (size_t)(bh * 32) * 16384 + lt * 16;
        u32x4 A[18], B[18];
#define LREC(dst, r) do { const unsigned char* _p = rbase + (size_t)(r) * REC_BYTES; const unsigned char* _u = ubase + (size_t)(r) * 16384; \
            _Pragma("unroll") for (int _c = 0; _c < 14; ++_c) dst[_c] = *(const u32x4*)(_p + _c * 4096); _Pragma("unroll") for (int _c = 0; _c < 4; ++_c) dst[14 + _c] = *(const u32x4*)(_u + _c * 4096); } while (0)
#define SREC(src, buf) do { _Pragma("unroll") for (int _c = 0; _c < 18; ++_c) *(LAS u32x4*)(lds + (buf) * IMG + _c * 4096 + lt * 16) = src[_c]; } while (0)
        LREC(B, 0); LREC(A, 1);
        SREC(B, 0);
        SCAN_BAR();
        for (int n = 0; n < 32; n += 2) {
            if (n + 2 < 32) LREC(B, n + 2);
            SREC(A, (n + 1) & 1);
            SCAN_BAR();
            if (n + 3 < 32) LREC(A, n + 3);
            if (n + 2 < 32) SREC(B, (n + 2) & 1);
            SCAN_BAR();
        }
#undef LREC
#undef SREC
        return;
    }
    const int sl0 = 2 * wave;
    f32x4 S[2][8]; bf16x8 Sb[2][4];
#pragma unroll
    for (int cg = 0; cg < 2; ++cg) {
#pragma unroll
        for (int i = 0; i < 8; ++i) S[cg][i] = (f32x4){0.f, 0.f, 0.f, 0.f};
#pragma unroll
        for (int i = 0; i < 4; ++i) Sb[cg][i] = (bf16x8){0, 0, 0, 0, 0, 0, 0, 0}; }
    const float gev = GE[bh * 32 + (lane & 31)];
    float ge_all = gev; asm volatile("s_waitcnt vmcnt(0)" : "+v"(ge_all) :: "memory");
    SCAN_BAR();
    for (int n = 0; n < 32; ++n) {
        const LAS unsigned char* img = lds + (n & 1) * IMG;
        const LAS unsigned char* rec = img + lane * 16;
        const float ge = __shfl(ge_all, n);
        f32x4 vn[2][4];
#pragma unroll
        for (int cg = 0; cg < 2; ++cg)
#pragma unroll
            for (int mt = 0; mt < 4; ++mt) { const u32x2 uu = *(const LAS u32x2*)(img + REC_BYTES + (((sl0 + cg) * 4 + mt) * 64 + lane) * 8); vn[cg][mt] = (f32x4){bflo(uu.x), bfhi(uu.x), bflo(uu.y), bfhi(uu.y)}; }
        bf16x8 fa[4], fb[4];
#define LDF(dst, off) do { _Pragma("unroll") for (int _i = 0; _i < 4; ++_i) dst[_i] = *(const LAS bf16x8*)(rec + (off) + _i * 1024); } while (0)
#define MM4(accv, fr_, bsel) do { _Pragma("unroll") for (int _i = 0; _i < 4; ++_i) { accv[0][_i] = MFMA16(fr_[_i], bsel(0), accv[0][_i]); accv[1][_i] = MFMA16(fr_[_i], bsel(1), accv[1][_i]); } } while (0)
#define SBK0(cg) Sb[cg][0]
#define SBK1(cg) Sb[cg][1]
#define SBK2(cg) Sb[cg][2]
#define SBK3(cg) Sb[cg][3]
#define VBK0(cg) Vb[cg][0]
#define VBK1(cg) Vb[cg][1]
        LDF(fa, 0); LDF(fb, 4096);
        MM4(vn, fa, SBK0); LDF(fa, 8192);
        MM4(vn, fb, SBK1); LDF(fb, 12288);
        MM4(vn, fa, SBK2); LDF(fa, 16384);
        MM4(vn, fb, SBK3); LDF(fb, 16384 + 4096);
        bf16x8 Vb[2][2];
#pragma unroll
        for (int cg = 0; cg < 2; ++cg) { Vb[cg][0] = pack8(vn[cg][0], vn[cg][1]); Vb[cg][1] = pack8(vn[cg][2], vn[cg][3]); }
        f32x4 o[2][4];
#pragma unroll
        for (int cg = 0; cg < 2; ++cg)
#pragma unroll
            for (int mt = 0; mt < 4; ++mt) o[cg][mt] = (f32x4){0.f, 0.f, 0.f, 0.f};
        MM4(o, fa, SBK0);  LDF(fa, 16384 + 8192);
        MM4(o, fb, SBK1);  LDF(fb, 16384 + 12288);
        MM4(o, fa, SBK2);  LDF(fa, 49152);
        MM4(o, fb, SBK3);  LDF(fb, 49152 + 4096);
        MM4(o, fa, VBK0);  LDF(fa, 32768);
        MM4(o, fb, VBK1);  LDF(fb, 32768 + 4096);
#pragma unroll
        for (int i = 0; i < 4; ++i) { S[0][i] = MFMA16(fa[i], Vb[0][0], S[0][i] * ge); S[1][i] = MFMA16(fa[i], Vb[1][0], S[1][i] * ge); }
        LDF(fa, 32768 + 8192);
#pragma unroll
        for (int i = 0; i < 4; ++i) { S[0][4 + i] = MFMA16(fb[i], Vb[0][0], S[0][4 + i] * ge); S[1][4 + i] = MFMA16(fb[i], Vb[1][0], S[1][4 + i] * ge); }
        LDF(fb, 32768 + 12288);
#pragma unroll
        for (int cg = 0; cg < 2; ++cg) { bf16_t* op = ORAW + ((size_t)b * SEQ + 64 * n + 4 * fq) * 512 + 128 * h + 16 * (sl0 + cg) + fr;
#pragma unroll
            for (int mt = 0; mt < 4; ++mt) { const unsigned w0 = cvt_pk_safe(o[cg][mt][0], o[cg][mt][1]), w1 = cvt_pk_safe(o[cg][mt][2], o[cg][mt][3]);
                op[(16 * mt + 0) * 512] = (bf16_t)(w0 & 0xffffu); op[(16 * mt + 1) * 512] = (bf16_t)(w0 >> 16); op[(16 * mt + 2) * 512] = (bf16_t)(w1 & 0xffffu); op[(16 * mt + 3) * 512] = (bf16_t)(w1 >> 16); } }
#pragma unroll
        for (int i = 0; i < 4; ++i) { S[0][i] = MFMA16(fa[i], Vb[0][1], S[0][i]); S[1][i] = MFMA16(fa[i], Vb[1][1], S[1][i]); }
#pragma unroll
        for (int i = 0; i < 4; ++i) { S[0][4 + i] = MFMA16(fb[i], Vb[0][1], S[0][4 + i]); S[1][4 + i] = MFMA16(fb[i], Vb[1][1], S[1][4 + i]); }
#undef LDF
#undef MM4
#pragma unroll
        for (int cg = 0; cg < 2; ++cg)
#pragma unroll
            for (int ks = 0; ks < 4; ++ks) Sb[cg][ks] = pack8(S[cg][2 * ks], S[cg][2 * ks + 1]);
        SCAN_BAR();
    }
}

typedef float f32x16 __attribute__((ext_vector_type(16)));
#define MFMA32(a, b, c) __builtin_amdgcn_mfma_f32_32x32x16_bf16((a), (b), (c), 0, 0, 0)
__device__ __forceinline__ void attn_task(int task, bf16_t* P1, int lane) {
    const int qb = task & 63, h = (task >> 6) & 7, b = task >> 9;
    const int r32 = lane & 31, hi = lane >> 5;
    const int q0 = qb * 32, qi = q0 + r32;
    bf16_t* base = P1 + (size_t)b * SEQ * N1 + 64 * h;
    bf16x8 qf[4];
#pragma unroll
    for (int c = 0; c < 4; ++c) qf[c] = *(const bf16x8*)(base + (size_t)qi * N1 + 2048 + 16 * c + 8 * hi);
    bf16x8 ua0, ua1, ones;
#pragma unroll
    for (int e = 0; e < 8; ++e) { const int key0 = 8 * (e >> 2) + 4 * hi + (e & 3); ua0[e] = (key0 > r32) ? (short)0x3F80 : (short)0; ua1[e] = (16 + key0 > r32) ? (short)0x3F80 : (short)0; ones[e] = (short)0x3F80; }
    f32x16 o[2];
#pragma unroll
    for (int i = 0; i < 16; ++i) { o[0][i] = 0.f; o[1][i] = 0.f; }
    float R = 0.f;
    const int ktd = q0 >> 6;
    bf16x8 kn[2][4];
#define LOAD_KV(KT) do { _Pragma("unroll") for (int mt = 0; mt < 2; ++mt) _Pragma("unroll") for (int c = 0; c < 4; ++c) \
        kn[mt][c] = *(const bf16x8*)(base + (size_t)((KT) * 64 + 32 * mt + r32) * N1 + 2560 + 16 * c + 8 * hi); } while (0)
    LOAD_KV(ktd);
    for (int kt = ktd; kt >= 0; --kt) {
        const int k0 = kt * 64; const bool diag = (kt == ktd);
        bf16x8 kf[2][4], vf[2][4];
#pragma unroll
        for (int mt = 0; mt < 2; ++mt)
#pragma unroll
            for (int c = 0; c < 4; ++c) { kf[mt][c] = kn[mt][c]; vf[mt][c] = *(const bf16x8*)(base + (size_t)((32 * mt + r32) * 32 + kt) * N1 + 3072 + 16 * c + 8 * hi); }
        if (kt > 0) LOAD_KV(kt - 1);
        f32x16 p[2];
#pragma unroll
        for (int i = 0; i < 16; ++i) { p[0][i] = 0.f; p[1][i] = 0.f; }
#pragma unroll
        for (int c = 0; c < 4; ++c) { p[0] = MFMA32(kf[0][c], qf[c], p[0]); p[1] = MFMA32(kf[1][c], qf[c], p[1]); }
        f32x16 lk[2]; float rs = 0.f;
#pragma unroll
        for (int mt = 0; mt < 2; ++mt)
#pragma unroll
            for (int r = 0; r < 16; ++r) { const int key = k0 + 32 * mt + (r & 3) + 8 * (r >> 2) + 4 * hi; const float z = p[mt][r];
                const float e = __builtin_amdgcn_exp2f(-fabsf(z)); const float sp = fmaxf(z, 0.f) + __builtin_amdgcn_logf(1.0f + e);
                const bool valid = !diag || key < qi; const float l = valid ? -sp : 0.f; lk[mt][r] = l; p[mt][r] = z - sp; rs += l; }
        bf16x8 lh[4];
#pragma unroll
        for (int kc = 0; kc < 4; ++kc) { u32x4 wh;
#pragma unroll
            for (int e2 = 0; e2 < 4; ++e2) wh[e2] = cvt_pk_bf16(lk[kc >> 1][8 * (kc & 1) + 2 * e2], lk[kc >> 1][8 * (kc & 1) + 2 * e2 + 1]);
            lh[kc] = __builtin_bit_cast(bf16x8, wh); }
        f32x16 cum[2];
#pragma unroll
        for (int i = 0; i < 16; ++i) { cum[0][i] = 0.f; cum[1][i] = 0.f; }
        cum[0] = MFMA32(ua0, lh[0], cum[0]); cum[0] = MFMA32(ua1, lh[1], cum[0]); cum[0] = MFMA32(ones, lh[2], cum[0]); cum[0] = MFMA32(ones, lh[3], cum[0]);
        cum[1] = MFMA32(ua0, lh[2], cum[1]); cum[1] = MFMA32(ua1, lh[3], cum[1]);
        bf16x8 pb[4];
#pragma unroll
        for (int kc = 0; kc < 4; ++kc) { u32x4 w; const int mt = kc >> 1;
#pragma unroll
            for (int e2 = 0; e2 < 4; ++e2) { const int ra = 8 * (kc & 1) + 2 * e2, rb = ra + 1;
                const int keya = k0 + 32 * mt + (ra & 3) + 8 * (ra >> 2) + 4 * hi, keyb = k0 + 32 * mt + (rb & 3) + 8 * (rb >> 2) + 4 * hi;
                float wa = __builtin_amdgcn_exp2f(p[mt][ra] + cum[mt][ra] + R), wb = __builtin_amdgcn_exp2f(p[mt][rb] + cum[mt][rb] + R);
                wa = (!diag || keya < qi) ? wa : 0.f; wb = (!diag || keyb < qi) ? wb : 0.f;
                w[e2] = cvt_pk_bf16(wa, wb); }
            pb[kc] = __builtin_bit_cast(bf16x8, w); }
#pragma unroll
        for (int kc = 0; kc < 4; ++kc) { o[0] = MFMA32(vf[0][kc], pb[kc], o[0]); o[1] = MFMA32(vf[1][kc], pb[kc], o[1]); }
        rs += __shfl_xor(rs, 32); R += rs;
        if (__ballot(R >= -150.f) == 0ull) break;
    }
#undef LOAD_KV
    bf16_t* qrow = base + (size_t)qi * N1 + 2048; const bf16_t* zrow = base + (size_t)qi * N1 + 3584;
#pragma unroll
    for (int mt = 0; mt < 2; ++mt)
#pragma unroll
        for (int g = 0; g < 4; ++g) { const int d = 32 * mt + 8 * g + 4 * hi; const u32x2 zz = *(const u32x2*)(zrow + d);
            const float v0 = o[mt][4 * g] * bflo(zz.x), v1 = o[mt][4 * g + 1] * bfhi(zz.x), v2 = o[mt][4 * g + 2] * bflo(zz.y), v3 = o[mt][4 * g + 3] * bfhi(zz.y);
            u32x2 w; w.x = cvt_pk_bf16(v0, v1); w.y = cvt_pk_bf16(v2, v3); *(u32x2*)(qrow + d) = w; }
}
__device__ __forceinline__ void attn_queue(unsigned* ctr, bf16_t* P1, int lane) {
    for (;;) { unsigned tk = 0; if (lane == 0) tk = atomicAdd(ctr, 1u); tk = (unsigned)__builtin_amdgcn_readfirstlane((int)tk); if (tk >= 16u * 8u * 64u) break; attn_task((int)tk, P1, lane); }
}

__global__ void __launch_bounds__(512, 2) fwd(Args a) {
    extern __shared__ __attribute__((aligned(16))) unsigned char lds_raw[];
    LAS unsigned char* lds = (LAS unsigned char*)lds_raw;
    cg::grid_group grid = cg::this_grid();
    const int tid = threadIdx.x, lane = tid & 63, wave = __builtin_amdgcn_readfirstlane(tid >> 6);
    const int G = gridDim.x, gw = blockIdx.x * NWAVES + wave, NGW = G * NWAVES;
    unsigned char* ws = a.ws;
    if (tid < 64) ((LAS unsigned*)(lds + 147456))[tid] = 0u;
    __syncthreads();
    XcdBarrier bar = xcd_barrier_post((unsigned*)(ws + WS_BAR), (volatile LAS unsigned*)(lds + 147456));
    bf16_t* W1T = (bf16_t*)(ws + WS_W1T); bf16_t* WGT = (bf16_t*)(ws + WS_WGT); bf16_t* WUPT = (bf16_t*)(ws + WS_WUPT); bf16_t* WOT = (bf16_t*)(ws + WS_WOT);
    float* BG = (float*)(ws + WS_BG); bf16_t* XN = (bf16_t*)(ws + WS_XN); bf16_t* P1 = (bf16_t*)(ws + WS_P1);
    bf16_t* QKVA = (bf16_t*)(ws + WS_QKVA); bf16_t* ORAW = (bf16_t*)(ws + WS_ORAW); bf16_t* MG = (bf16_t*)(ws + WS_MG);
    bf16_t* GSC = (bf16_t*)(ws + WS_GSC) + (size_t)blockIdx.x * 65536; bf16_t* GY = (bf16_t*)((unsigned char*)a.out + OUT_GY) + (size_t)blockIdx.x * 65536;

    {
        if (blockIdx.x == 0 && tid == 0) *(unsigned*)(ws + WS_CTL) = 0u;
        LAS float* scr = (LAS float*)(lds + wave * 8704);
        LAS float* W8T = (LAS float*)(lds + 69632);
        for (int i = 0; i < 16; ++i) { const int idx = tid + 512 * i, c = idx & 7, d = idx >> 3; W8T[c * 1024 + d] = a.w_in[(size_t)d * PROJ + 2048 + c]; }
        for (int it = gw; it < 4096; it += NGW) {
            int r = it;
            if (r < 2048) { const int kb = r >> 7, nb = r & 127, pn = nb >> 3, p0 = 32 * (nb & 7); const int logical = pn * 256 + 64 * ((p0 >> 5) & 3) + 32 * (p0 >> 7);
                const int src = logical < 2048 ? logical : logical + 8;
                p0_transpose_item(a.w_in, PROJ, src, 64 * kb, W1T, 32 * nb, 64 * kb, scr, lane); continue; }
            r -= 2048;
            if (r < 1024) { const int kb = r >> 6, nb = r & 63; p0_transpose_item(a.w_in, PROJ, 4104 + 32 * nb, 64 * kb, WGT, 32 * nb, 64 * kb, scr, lane); continue; }
            r -= 1024;
            if (r < 256) { const int kb = r >> 5, nb = r & 31; p0_transpose_item(a.w_up_a, DM, 32 * nb, 64 * kb, WUPT, 32 * nb, 64 * kb, scr, lane); continue; }
            r -= 256;
            if (r < 256) { const int kb = r >> 5, nb = r & 31; p0_transpose_item(a.w_up_b, DM, 32 * nb, 64 * kb, WUPT, 32 * nb, 512 + 64 * kb, scr, lane); continue; }
            r -= 256;
            { const int kb = r >> 5, nb = r & 31; p0_transpose_item(a.w_out, DM, 32 * nb, 64 * kb, WOT, 32 * nb, 64 * kb, scr, lane); }
        }
        __syncthreads();
        f32x4 gv[4];
#pragma unroll
        for (int j = 0; j < 4; ++j) gv[j] = ((const f32x4*)a.norm_gain)[lane + 64 * j];
        for (int rb = gw * 4; rb < M; rb += NGW * 4) {
            f32x4 v[4][4]; float ss[4];
#pragma unroll
            for (int q = 0; q < 4; ++q) { const f32x4* xr = (const f32x4*)(a.x + (size_t)(rb + q) * DM) + lane; ss[q] = 0.f;
#pragma unroll
                for (int j = 0; j < 4; ++j) { v[q][j] = __builtin_nontemporal_load(xr + 64 * j); } }
#pragma unroll
            for (int q = 0; q < 4; ++q)
#pragma unroll
                for (int j = 0; j < 4; ++j) ss[q] += (v[q][j][0] * v[q][j][0] + v[q][j][1] * v[q][j][1]) + (v[q][j][2] * v[q][j][2] + v[q][j][3] * v[q][j][3]);
#pragma unroll
            for (int o = 1; o < 64; o <<= 1) {
#pragma unroll
                for (int q = 0; q < 4; ++q) ss[q] += __shfl_xor(ss[q], o); }
            float bg[4][8];
#pragma unroll
            for (int q = 0; q < 4; ++q) { const float rstd = __builtin_amdgcn_rsqf(ss[q] * (1.0f / DM) + EPS);
#pragma unroll
                for (int c = 0; c < 8; ++c) bg[q][c] = 0.f;
                u32x2* o8 = (u32x2*)(XN + (size_t)(rb + q) * DM) + lane;
#pragma unroll
                for (int j = 0; j < 4; ++j) { v[q][j] = v[q][j] * rstd * gv[j]; u32x2 w; w.x = cvt_pk_bf16(v[q][j][0], v[q][j][1]); w.y = cvt_pk_bf16(v[q][j][2], v[q][j][3]); o8[64 * j] = w; } }
#pragma unroll
            for (int j = 0; j < 4; ++j)
#pragma unroll
                for (int c = 0; c < 8; ++c) { const f32x4 wv = *(const LAS f32x4*)(W8T + c * 1024 + 4 * lane + 256 * j);
#pragma unroll
                    for (int q = 0; q < 4; ++q) bg[q][c] += (v[q][j][0] * wv[0] + v[q][j][1] * wv[1]) + (v[q][j][2] * wv[2] + v[q][j][3] * wv[3]); }
#pragma unroll
            for (int q = 0; q < 4; ++q) { const bool b0 = lane & 1, b1 = lane & 2, b2 = lane & 4;
                float t4[4];
#pragma unroll
                for (int c = 0; c < 4; ++c) { const float snd = b0 ? bg[q][c] : bg[q][c + 4], keep = b0 ? bg[q][c + 4] : bg[q][c]; t4[c] = keep + __shfl_xor(snd, 1); }
                float t2[2];
#pragma unroll
                for (int c = 0; c < 2; ++c) { const float snd = b1 ? t4[c] : t4[c + 2], keep = b1 ? t4[c + 2] : t4[c]; t2[c] = keep + __shfl_xor(snd, 2); }
                float t1; { const float snd = b2 ? t2[0] : t2[1], keep = b2 ? t2[1] : t2[0]; t1 = keep + __shfl_xor(snd, 4); }
                t1 += __shfl_xor(t1, 8); t1 += __shfl_xor(t1, 16); t1 += __shfl_xor(t1, 32);
                if (lane < 8) BG[(size_t)(rb + q) * 8 + (b0 ? 4 : 0) + (b1 ? 2 : 0) + (b2 ? 1 : 0)] = t1; }
        }
    }
    if (a.never) grid.sync();
    xcd_barrier(bar);

    {
        pg8::SchedPlain S{(const char*)XN, (const char*)W1T, 16, 128, 16, G, (int)blockIdx.x};
        pg8::Epi1 E{P1, a.sb_q_gain, a.sb_k_gain};
        pg8::gemm_phase<pg8::Epi1, pg8::SchedPlain>(lds, S, E);
    }
    xcd_barrier(bar);

    {
        for (int run = gw; run < M / 16; run += NGW) {
            const int t0 = run * 16; const bool seq_start = (t0 % SEQ) == 0;
#pragma unroll
            for (int g = 0; g < 3; ++g) {
                float cw[4][8];
#pragma unroll
                for (int tp = 0; tp < 4; ++tp) { const f32x4 c0 = *(const f32x4*)(a.conv_w + tp * 1536 + 512 * g + 8 * lane), c1 = *(const f32x4*)(a.conv_w + tp * 1536 + 512 * g + 8 * lane + 4);
#pragma unroll
                    for (int e = 0; e < 4; ++e) { cw[tp][e] = c0[e]; cw[tp][4 + e] = c1[e]; } }
                u32x4 rows[19];
#pragma unroll
                for (int k = 0; k < 19; ++k) rows[k] = (k < 3 && seq_start) ? (u32x4){0u, 0u, 0u, 0u} : *(const u32x4*)(P1 + (size_t)(t0 - 3 + k) * N1 + 512 * g + 8 * lane);
#pragma unroll
                for (int tt = 0; tt < 16; ++tt) {
                    float val[8]; float ss = 0.f;
#pragma unroll
                    for (int e2 = 0; e2 < 4; ++e2) {
                        const unsigned w0 = rows[tt][e2], w1 = rows[tt + 1][e2], w2 = rows[tt + 2][e2], w3 = rows[tt + 3][e2];
                        float lo = cw[0][2 * e2] * bflo(w0) + cw[1][2 * e2] * bflo(w1) + cw[2][2 * e2] * bflo(w2) + cw[3][2 * e2] * bflo(w3);
                        float hi = cw[0][2 * e2 + 1] * bfhi(w0) + cw[1][2 * e2 + 1] * bfhi(w1) + cw[2][2 * e2 + 1] * bfhi(w2) + cw[3][2 * e2 + 1] * bfhi(w3);
                        lo = lo * sigmoidf_(lo); hi = hi * sigmoidf_(hi);
                        val[2 * e2] = lo; val[2 * e2 + 1] = hi; ss += lo * lo + hi * hi;
                    }
                    float sc = 1.f;
                    if (g < 2) { ss = red16(ss); sc = __builtin_amdgcn_rsqf(ss + EPS); if (g == 0) sc *= 0.08838834764831845f; }
                    u32x4 w; w.x = cvt_pk_bf16(val[0] * sc, val[1] * sc); w.y = cvt_pk_bf16(val[2] * sc, val[3] * sc); w.z = cvt_pk_bf16(val[4] * sc, val[5] * sc); w.w = cvt_pk_bf16(val[6] * sc, val[7] * sc);
                    *(u32x4*)(QKVA + (size_t)(t0 + tt) * 1536 + 512 * g + 8 * lane) = w;
                }
            }
            { const int tk = lane >> 2, hh = lane & 3; float* bgp = BG + (size_t)(t0 + tk) * 8; const float blv = bgp[hh], dlv = bgp[4 + hh];
              const float beta = sigmoidf_(blv); const float xx = dlv + a.dt_bias[hh]; const float sp = fmaxf(xx, 0.f) + log1pf(expf(-fabsf(xx)));
              const float gg = -expf(a.a_log[hh]) * sp; bgp[hh] = beta; bgp[4 + hh] = gg; }
        }
    }
    unsigned* actr = (unsigned*)(ws + WS_CTL);
    unsigned char* REC = (unsigned char*)a.out + OUT_REC; bf16_t* UF = (bf16_t*)(ws + WS_UF); float* GE = (float*)(ws + WS_GE);
    if (G == 256) { asm volatile("s_waitcnt vmcnt(0)" ::: "memory"); __syncthreads();
        const int bb = blockIdx.x >> 4, n0 = 2 * (blockIdx.x & 15); dn_prep((bb * 4 + (wave & 3)) * 32 + n0 + (wave >> 2), lds + wave * 18432, QKVA, BG, REC, UF, GE, lane); }
    else { xcd_barrier(bar); for (int task = blockIdx.x * 8 + wave; task < 2048; task += G * 8) dn_prep(task, lds + wave * 18432, QKVA, BG, REC, UF, GE, lane); }
    xcd_barrier(bar);

    if (G == 256) { if (((blockIdx.x >> 3) & 3) == 0) dn_scan_wg((blockIdx.x >> 5) * 8 + (blockIdx.x & 7), lds, REC, UF, GE, ORAW, tid, wave, lane); }
    else { for (int bh = blockIdx.x; bh < 64; bh += G) dn_scan_wg(bh, lds, REC, UF, GE, ORAW, tid, wave, lane); }
    attn_queue(actr, P1, lane);
    xcd_barrier(bar);

    {
        int lane4 = lane; asm volatile("" : "+v"(lane4));
        f32x4 g0 = *(const f32x4*)(a.dn_out_gain + ((8 * lane4) & 127)), g1 = *(const f32x4*)(a.dn_out_gain + ((8 * lane4) & 127) + 4);
        for (int rb = gw * 4; rb < M; rb += NGW * 4) {
            u32x4 ov4[4], zv4[4];
#pragma unroll
            for (int q = 0; q < 4; ++q) { ov4[q] = *(const u32x4*)(ORAW + (size_t)(rb + q) * 512 + 8 * lane); zv4[q] = *(const u32x4*)(P1 + (size_t)(rb + q) * N1 + 1536 + 8 * lane); }
#pragma unroll
            for (int q = 0; q < 4; ++q) { const u32x4 ov = ov4[q], zv = zv4[q];
                float v[8] = {bflo(ov.x), bfhi(ov.x), bflo(ov.y), bfhi(ov.y), bflo(ov.z), bfhi(ov.z), bflo(ov.w), bfhi(ov.w)};
                const float z[8] = {bflo(zv.x), bfhi(zv.x), bflo(zv.y), bfhi(zv.y), bflo(zv.z), bfhi(zv.z), bflo(zv.w), bfhi(zv.w)};
                float ss = 0.f;
#pragma unroll
                for (int i = 0; i < 8; ++i) ss += v[i] * v[i];
                ss = red16(ss);
                const float rs = __builtin_amdgcn_rsqf(ss * (1.0f / 128.0f) + EPS);
#pragma unroll
                for (int i = 0; i < 8; ++i) v[i] = v[i] * rs * (i < 4 ? g0[i & 3] : g1[i & 3]) * z[i];
                u32x4 w; w.x = cvt_pk_bf16(v[0], v[1]); w.y = cvt_pk_bf16(v[2], v[3]); w.z = cvt_pk_bf16(v[4], v[5]); w.w = cvt_pk_bf16(v[6], v[7]);
                *(u32x4*)(P1 + (size_t)(rb + q) * N1 + 1536 + 8 * lane) = w; }
        }
    }
    xcd_barrier(bar);

    {
        pg8::SchedP5 S{(const char*)XN, (const char*)WGT, (const char*)P1, (const char*)WUPT, G, (int)blockIdx.x};
        pg8::Epi5 E{a.b_gate, GSC, GY, MG};
        pg8::gemm_phase<pg8::Epi5, pg8::SchedP5>(lds, S, E);
    }
    xcd_barrier(bar);

    {
        pg8::SchedPlain S{(const char*)MG, (const char*)WOT, 16, 128, 4, G, (int)blockIdx.x};
        pg8::Epi6 E{a.x, a.out};
        pg8::gemm_phase<pg8::Epi6, pg8::SchedPlain>(lds, S, E);
    }
}

extern "C" void kernel_launch(void* const* d_in, const int* in_sizes, int n_in, void* d_out, int out_size, void* d_ws, size_t ws_size, hipStream_t stream) {
    static int grid = 0;
    if (grid == 0) {
        if (n_in != 13 || out_size != M * DM || ws_size < WS_END) { fprintf(stderr, "kernel_launch: unexpected problem (n_in %d out %d ws %zu)\n", n_in, out_size, ws_size); grid = -1; return; }
        int dev = 0, cus = 0, per_cu = 0;
        (void)hipGetDevice(&dev); (void)hipDeviceGetAttribute(&cus, hipDeviceAttributeMultiprocessorCount, dev);
        (void)hipFuncSetAttribute((const void*)fwd, hipFuncAttributeMaxDynamicSharedMemorySize, LDS_BYTES);
        (void)hipOccupancyMaxActiveBlocksPerMultiprocessor(&per_cu, (const void*)fwd, NWAVES * 64, LDS_BYTES);
        if (per_cu < 1) fprintf(stderr, "kernel_launch: occupancy query says %d blocks per CU\n", per_cu);
        grid = cus;
    }
    if (grid < 0) return;
    (void)hipMemsetAsync((unsigned char*)d_ws + WS_BAR, 0, XCD_BAR_WORDS * 4, stream);
    Args a{};
    a.x = (const float*)d_in[0]; a.norm_gain = (const float*)d_in[1]; a.w_in = (const float*)d_in[2]; a.b_gate = (const float*)d_in[3]; a.conv_w = (const float*)d_in[4];
    a.a_log = (const float*)d_in[5]; a.dt_bias = (const float*)d_in[6]; a.dn_out_gain = (const float*)d_in[7]; a.sb_q_gain = (const float*)d_in[8]; a.sb_k_gain = (const float*)d_in[9];
    a.w_up_a = (const float*)d_in[10]; a.w_up_b = (const float*)d_in[11]; a.w_out = (const float*)d_in[12];
    a.out = (float*)d_out; a.ws = (unsigned char*)d_ws;
    void* args[] = {&a};
    hipError_t e = hipLaunchCooperativeKernel((const void*)fwd, dim3(grid), dim3(NWAVES * 64), args, LDS_BYTES, stream);
    if (e != hipSuccess) fprintf(stderr, "kernel_launch: cooperative launch failed: %s (grid %d)\n", hipGetErrorString(e), grid);
}
```

```cpp
#include <hip/hip_runtime.h>
#include <hip/hip_cooperative_groups.h>
#include <cstdio>
#include <cstdint>
namespace cg = cooperative_groups;

#define LAS __attribute__((address_space(3)))
typedef unsigned short bf16_t;
typedef short bf16x8 __attribute__((ext_vector_type(8)));
typedef float f32x4 __attribute__((ext_vector_type(4)));
typedef unsigned u32x4 __attribute__((ext_vector_type(4)));
typedef unsigned u32x2 __attribute__((ext_vector_type(2)));
typedef __bf16 bf16x2_t __attribute__((ext_vector_type(2)));

constexpr int M = 32768, DM = 1024, SEQ = 2048;
constexpr int N1 = 4096;
constexpr int PROJ = 6152;
constexpr float EPS = 1e-6f;
constexpr float QSCALE = 0.125f * 1.4426950408889634f;
constexpr int NWAVES = 8;
constexpr size_t MiB = (size_t)1 << 20;
constexpr size_t WS_CTL = 0, WS_W1T = 1 * MiB, WS_WGT = 9 * MiB, WS_WUPT = 13 * MiB, WS_WOT = 15 * MiB, WS_BG = 17 * MiB, WS_XN = 18 * MiB, WS_P1 = 82 * MiB,
                 WS_QKVA = 338 * MiB, WS_ORAW = 434 * MiB, WS_UF = 466 * MiB, WS_END = 498 * MiB;
constexpr size_t WS_GE = 4096;
constexpr size_t WS_BAR = 65536;
constexpr size_t WS_MG = WS_QKVA;
constexpr size_t WS_GSC = WS_ORAW;
constexpr size_t OUT_REC = 0, OUT_GY = 64 * MiB;
constexpr int REC_BYTES = 57344;
constexpr int LDS_BYTES = 147456 + 256;

typedef float f32x2_t __attribute__((ext_vector_type(2)));
__device__ __forceinline__ unsigned cvt_pk_bf16(float lo, float hi) { unsigned r; asm volatile("s_nop 1\n\tv_cvt_pk_bf16_f32 %0, %1, %2\n\ts_nop 1" : "=v"(r) : "v"(lo), "v"(hi)); return r; }
__device__ __forceinline__ unsigned cvt_pk_safe(float lo, float hi) { unsigned r; asm volatile("s_nop 7\n\ts_nop 7\n\ts_nop 3\n\tv_cvt_pk_bf16_f32 %0, %1, %2\n\ts_nop 1" : "=v"(r) : "v"(lo), "v"(hi)); return r; }
__device__ __forceinline__ float bflo(unsigned w) { return __uint_as_float(w << 16); }
__device__ __forceinline__ float bfhi(unsigned w) { return __uint_as_float(w & 0xffff0000u); }
__device__ __forceinline__ float sigmoidf_(float v) { return __builtin_amdgcn_rcpf(1.0f + __expf(-v)); }
__device__ __forceinline__ float wave_sum(float v) {
#pragma unroll
    for (int o = 1; o < 64; o <<= 1) v += __shfl_xor(v, o);
    return v;
}
#define DPP_ADD(v, CTRL) v += __builtin_bit_cast(float, __builtin_amdgcn_update_dpp(0, __builtin_bit_cast(int, v), CTRL, 0xF, 0xF, true))
__device__ __forceinline__ float red16(float v) {
    DPP_ADD(v, 0xB1); DPP_ADD(v, 0x4E); DPP_ADD(v, 0x141); DPP_ADD(v, 0x140);
    return v;
}

namespace pg8 {
constexpr int BM = 256, BK = 64, HALF = 128, HTB = HALF * BK * 2, NXCD = 8, WGM = 8;
constexpr int PITCH = 2048;
__device__ __forceinline__ int lds_byte(int r, int c) { const int st = (r >> 4) * 2 + (c >> 5), rr = r & 15, cc = c & 31, ob = rr * 64 + cc * 2; return st * 1024 + (ob ^ (((ob >> 9) & 1) << 5)); }
__device__ __forceinline__ void stage_rc(int b, int& R, int& C) { const int st = b / 1024, sb = b % 1024, swz = sb ^ (((sb >> 9) & 1) << 5); R = (st >> 1) * 16 + swz / 64; C = (st & 1) * 32 + (swz % 64) / 2; }
__device__ __forceinline__ int perm32(int rho) { const int n = rho >> 4, i = rho & 15; return 8 * (i >> 2) + 4 * n + (i & 3); }

struct Unit { const char* A; const char* B; int nt, pm, pn, sub, ap; };

__device__ __forceinline__ void tile_of(int L, int nM, int nN, int& pm, int& pn) {
    const int nwg = nM * nN; int wgid = L;
    { const int q = nwg / NXCD, r = nwg % NXCD, xcd = wgid % NXCD, off = wgid / NXCD; wgid = (xcd < r ? xcd * (q + 1) : r * (q + 1) + (xcd - r) * q) + off; }
    const int nig = WGM * nN, gid = wgid / nig, fm = gid * WGM, gsz = (nM - fm) < WGM ? (nM - fm) : WGM;
    pm = fm + ((wgid % nig) % gsz); pn = (wgid % nig) / gsz;
}
struct SchedPlain {
    const char* A; const char* B; int nt, nM, nN, G, c;
    __device__ __forceinline__ bool next(int i, Unit& u) const {
        const long L = (long)i * G + c; if (L >= (long)nM * nN) return false;
        tile_of((int)L, nM, nN, u.pm, u.pn);
        u.A = A + (size_t)u.pm * BM * PITCH; u.B = B + (size_t)u.pn * BM * PITCH; u.nt = nt; u.sub = 0; u.ap = 0; return true;
    }
};
struct SchedP5 {
    const char* XN; const char* WG; const char* P1; const char* WUP; int G, c;
    __device__ __forceinline__ bool next(int i, Unit& u) const {
        const int ti = i >> 2, sub = i & 3; const long L = (long)ti * G + c; if (L >= 128 * 4) return false;
        tile_of((int)L, 128, 4, u.pm, u.pn); u.sub = sub;
        if (sub == 0)      { u.A = XN + (size_t)u.pm * BM * PITCH;            u.B = WG + (size_t)(u.pn * BM) * PITCH;         u.nt = 16; u.ap = 0; }
        else if (sub == 1) { u.A = P1 + (size_t)u.pm * BM * 8192 + 1536 * 2; u.B = WUP + (size_t)(u.pn * BM) * PITCH;        u.nt = 8;  u.ap = 1; }
        else if (sub == 2) { u.A = XN + (size_t)u.pm * BM * PITCH;            u.B = WG + (size_t)(1024 + u.pn * BM) * PITCH;  u.nt = 16; u.ap = 0; }
        else               { u.A = P1 + (size_t)u.pm * BM * 8192 + 2048 * 2; u.B = WUP + (size_t)(u.pn * BM) * PITCH + 1024; u.nt = 8;  u.ap = 1; }
        return true;
    }
};

template <class Epi, class Sched>
__device__ __forceinline__ void gemm_phase(LAS unsigned char* lds, const Sched& S, const Epi& E) {
    int tid = threadIdx.x; asm volatile("" : "+v"(tid));
    const int wid = __builtin_amdgcn_readfirstlane(tid >> 6), lane = tid & 63, wr = wid >> 2, wc = wid & 3, fr = lane & 15, fq = lane >> 4;
    unsigned vRC, voffB;
    { int R, C; stage_rc(tid * 16, R, C); const int Rb = (R & ~31) + perm32(R & 31); vRC = (unsigned)(R * PITCH + C * 2); voffB = (unsigned)(Rb * PITCH + C * 2); }
#define PG8_VA(ap) ((ap) ? (((vRC >> 11) << 13) + (vRC & 2047u)) : vRC)
    const size_t kstep = (size_t)(BK * 2);
    const size_t hstep = (size_t)HALF * PITCH;
    const unsigned ldsw = (unsigned)wid * 1024u;
    const int aoff = lds_byte(wr * 64 + fr, fq * 8), boff = lds_byte(wc * 32 + fr, fq * 8);
#define PG8_SA(b, h) (((b) * 2 + (h)) * HTB)
#define PG8_SB(b, h) ((4 + (b) * 2 + (h)) * HTB)
#define PG8_STAGE(bufoff, gbase, voff, d64) do { _Pragma("unroll") for (int _i = 0; _i < 2; ++_i) \
        __builtin_amdgcn_global_load_lds((const unsigned*)((const char*)(gbase) + (size_t)_i * (d64) + (voff)), (LAS unsigned*)(lds + (bufoff) + ldsw + _i * 8192), 16, 0, 0); } while (0)
#define PG8_STAGEB(bufoff, gbase) PG8_STAGE(bufoff, gbase, voffB, (size_t)64 * PITCH)
#define PG8_LDA(dst, b, h) do { _Pragma("unroll") for (int m = 0; m < 4; ++m) _Pragma("unroll") for (int k = 0; k < 2; ++k) dst[m][k] = *(const LAS bf16x8*)(lds + PG8_SA(b, h) + aoff + m * 2048 + k * 1024); } while (0)
#define PG8_LDB(dst, b, h) do { _Pragma("unroll") for (int n = 0; n < 2; ++n) _Pragma("unroll") for (int k = 0; k < 2; ++k) dst[n][k] = *(const LAS bf16x8*)(lds + PG8_SB(b, h) + boff + n * 2048 + k * 1024); } while (0)
#define PG8_MMA(ai, bj, At, Bt) do { __builtin_amdgcn_s_setprio(1); _Pragma("unroll") for (int m = 0; m < 4; ++m) _Pragma("unroll") for (int n = 0; n < 2; ++n) _Pragma("unroll") for (int k = 0; k < 2; ++k) \
        acc[ai][bj][m][n] = __builtin_amdgcn_mfma_f32_16x16x32_bf16(Bt[n][k], At[m][k], acc[ai][bj][m][n], 0, 0, 0); __builtin_amdgcn_s_setprio(0); } while (0)
#define PG8_WAIT_V(n) asm volatile("s_waitcnt vmcnt(" #n ")" ::: "memory")
#define PG8_WAIT_L(n) asm volatile("s_waitcnt lgkmcnt(" #n ")" ::: "memory")
#define PG8_BAR __builtin_amdgcn_s_barrier()
#define PG8_SCHED __builtin_amdgcn_sched_barrier(0)
    Unit cur, nxt; int ui = 0;
    if (!S.next(0, cur)) return;
    f32x4 acc[2][2][4][2];
#pragma unroll
    for (int a = 0; a < 2; ++a)
#pragma unroll
        for (int b = 0; b < 2; ++b)
#pragma unroll
            for (int m = 0; m < 4; ++m)
#pragma unroll
                for (int n = 0; n < 2; ++n) acc[a][b][m][n] = (f32x4){0.f, 0.f, 0.f, 0.f};
    bf16x8 At[4][2], B0[2][2], B1[2][2];
    const char* cA = cur.A; const char* cB = cur.B;
    unsigned voffA = PG8_VA(cur.ap);
    size_t hA = cur.ap ? (size_t)HALF * 8192 : hstep;
    PG8_STAGEB(PG8_SB(0, 0), cB); PG8_STAGEB(PG8_SB(0, 1), cB + hstep); PG8_STAGE(PG8_SA(0, 0), cA, voffA, hA >> 1); PG8_STAGE(PG8_SA(0, 1), cA + hA, voffA, hA >> 1);
    if (wr == 1) PG8_BAR;
    PG8_WAIT_V(2); PG8_BAR;
    PG8_STAGEB(PG8_SB(1, 0), cB + kstep); PG8_STAGE(PG8_SA(1, 0), cA + kstep, voffA, hA >> 1); PG8_STAGEB(PG8_SB(1, 1), cB + hstep + kstep);
    PG8_WAIT_V(6); PG8_BAR;
    for (;;) {
        const bool has_next = S.next(ui + 1, nxt);
        const char* nA = has_next ? nxt.A : cA; const char* nB = has_next ? nxt.B : cB;
        const int nap = has_next ? nxt.ap : cur.ap;
        const unsigned voffN = PG8_VA(nap);
        const size_t hN = nap ? (size_t)HALF * 8192 : hstep;
        const int nt = cur.nt;
        for (int t = 0; t < nt; t += 2) {
            const bool last = (t == nt - 2);
            const char* a1 = cA + (size_t)(t + 1) * kstep;
            const char* a2 = last ? nA : cA + (size_t)(t + 2) * kstep; const char* b2 = last ? nB : cB + (size_t)(t + 2) * kstep;
            const char* a3 = a2 + kstep; const char* b3 = b2 + kstep;
            const unsigned voff2 = last ? voffN : voffA;
            const size_t h2 = last ? hN : hA;
            PG8_LDB(B0, 0, 0); PG8_LDB(B1, 0, 1); PG8_SCHED; PG8_LDA(At, 0, 0); PG8_STAGE(PG8_SA(1, 1), a1 + hA, voffA, hA >> 1);
            PG8_WAIT_V(8); PG8_WAIT_L(0); PG8_BAR; PG8_MMA(0, 0, At, B0); PG8_MMA(0, 1, At, B1); PG8_BAR; PG8_SCHED;
            PG8_LDA(At, 0, 1); PG8_STAGEB(PG8_SB(0, 0), b2); PG8_STAGEB(PG8_SB(0, 1), b2 + hstep); PG8_STAGE(PG8_SA(0, 0), a2, voff2, h2 >> 1);
            PG8_WAIT_V(8); PG8_WAIT_L(0); PG8_BAR; PG8_MMA(1, 0, At, B0); PG8_MMA(1, 1, At, B1); PG8_BAR; PG8_SCHED;
            PG8_LDB(B0, 1, 0); PG8_LDB(B1, 1, 1); PG8_SCHED; PG8_LDA(At, 1, 0); PG8_STAGE(PG8_SA(0, 1), a2 + h2, voff2, h2 >> 1);
            PG8_WAIT_V(8); PG8_WAIT_L(0); PG8_BAR; PG8_MMA(0, 0, At, B0); PG8_MMA(0, 1, At, B1); PG8_BAR; PG8_SCHED;
            PG8_LDA(At, 1, 1); PG8_STAGEB(PG8_SB(1, 0), b3); PG8_STAGEB(PG8_SB(1, 1), b3 + hstep); PG8_STAGE(PG8_SA(1, 0), a3, voff2, h2 >> 1);
            PG8_WAIT_V(8); PG8_WAIT_L(0); PG8_BAR; PG8_MMA(1, 0, At, B0); PG8_MMA(1, 1, At, B1); PG8_BAR; PG8_SCHED;
        }
        if (wr == 0) PG8_BAR;
        E(acc, cur, wr, wc, fr, fq);
        if (!has_next) break;
#pragma unroll
        for (int a = 0; a < 2; ++a)
#pragma unroll
            for (int b = 0; b < 2; ++b)
#pragma unroll
                for (int m = 0; m < 4; ++m)
#pragma unroll
                    for (int n = 0; n < 2; ++n) acc[a][b][m][n] = (f32x4){0.f, 0.f, 0.f, 0.f};
        cur = nxt; cA = nA; cB = nB; ++ui; voffA = voffN; hA = hN;
        if (wr == 1) PG8_BAR;
    }
    PG8_WAIT_V(0);
    PG8_BAR;
#undef PG8_SA
#undef PG8_SB
#undef PG8_STAGE
#undef PG8_STAGEB
#undef PG8_VA
#undef PG8_LDA
#undef PG8_LDB
#undef PG8_MMA
#undef PG8_WAIT_V
#undef PG8_WAIT_L
#undef PG8_BAR
#undef PG8_SCHED
}

struct Epi1 {
    bf16_t* P1; const float* qg; const float* kg;
    __device__ __forceinline__ void operator()(const f32x4 (&acc)[2][2][4][2], const Unit& u, int wr, int wc, int fr, int fq) const {
        const int pn = u.pn;
        const int kind = (pn < 6) ? 0 : (pn < 8) ? 1 : (pn < 10) ? 2 : (pn < 12) ? 3 : (pn < 14) ? 4 : 1;
        const int col0 = pn * BM + wc * 64 + 8 * fq;
        const size_t row0 = (size_t)u.pm * BM + wr * 64 + fr;
        f32x4 gn[2][2];
#pragma unroll
        for (int bj = 0; bj < 2; ++bj)
#pragma unroll
            for (int n = 0; n < 2; ++n) gn[bj][n] = (f32x4){1.f, 1.f, 1.f, 1.f};
        if (kind >= 2) { const float* g = (kind == 2) ? qg : kg; const float sc = (kind == 2) ? QSCALE : 1.0f;
#pragma unroll
            for (int bj = 0; bj < 2; ++bj)
#pragma unroll
                for (int n = 0; n < 2; ++n) gn[bj][n] = *(const f32x4*)(g + 32 * bj + 8 * fq + 4 * n) * sc; }
        if (kind == 4) {
            const int hh = 4 * (pn - 12) + wc; const int tok0 = u.pm * BM + wr * 64 + fr; const int bb = tok0 >> 11;
            bf16_t* vb = P1 + (size_t)bb * SEQ * N1 + 3072 + 64 * hh;
#pragma unroll
            for (int ai = 0; ai < 2; ++ai)
#pragma unroll
                for (int m = 0; m < 4; ++m) { const int sq = (tok0 + ai * HALF + m * 16) & (SEQ - 1); const int cs = (sq & 48) | ((sq & 4) << 1) | ((sq & 8) >> 1) | (sq & 3);
                    unsigned off = (unsigned)((sq >> 6) * N1 + cs + (8 * fq) * 32 * N1); asm volatile("" : "+v"(off));
#pragma unroll
                    for (int bj = 0; bj < 2; ++bj)
#pragma unroll
                        for (int n = 0; n < 2; ++n) { const f32x4 x = acc[ai][bj][m][n]; const unsigned w0 = cvt_pk_bf16(x[0], x[1]), w1 = cvt_pk_bf16(x[2], x[3]); bf16_t* bp = vb + off + (unsigned)((32 * bj + 4 * n) * 32 * N1);
                            bp[0 * 32 * N1] = (bf16_t)(w0 & 0xffffu); bp[1 * 32 * N1] = (bf16_t)(w0 >> 16); bp[2 * 32 * N1] = (bf16_t)(w1 & 0xffffu); bp[3 * 32 * N1] = (bf16_t)(w1 >> 16); }
                    asm volatile("" ::: "memory"); }
            return;
        }
#pragma unroll
        for (int ai = 0; ai < 2; ++ai)
#pragma unroll
            for (int m = 0; m < 4; ++m) {
                bf16_t* rowp = P1 + (row0 + ai * HALF + m * 16) * N1 + col0;
                float rs = 1.f;
                if (kind >= 2) { float ss = 0.f;
#pragma unroll
                    for (int bj = 0; bj < 2; ++bj)
#pragma unroll
                        for (int n = 0; n < 2; ++n) { const f32x4 x = acc[ai][bj][m][n]; ss += (x[0] * x[0] + x[1] * x[1]) + (x[2] * x[2] + x[3] * x[3]); }
                    ss += __shfl_xor(ss, 16); ss += __shfl_xor(ss, 32);
                    rs = __builtin_amdgcn_rsqf(ss * (1.0f / 64.0f) + EPS); }
#pragma unroll
                for (int bj = 0; bj < 2; ++bj) { f32x4 v0 = acc[ai][bj][m][0], v1 = acc[ai][bj][m][1];
                    if (kind == 1) {
#pragma unroll
                        for (int j = 0; j < 4; ++j) { v0[j] = v0[j] * sigmoidf_(v0[j]); v1[j] = v1[j] * sigmoidf_(v1[j]); } }
                    else if (kind >= 2) { v0 = v0 * rs * gn[bj][0]; v1 = v1 * rs * gn[bj][1]; }
                    u32x4 w; w.x = cvt_pk_bf16(v0[0], v0[1]); w.y = cvt_pk_bf16(v0[2], v0[3]); w.z = cvt_pk_bf16(v1[0], v1[1]); w.w = cvt_pk_bf16(v1[2], v1[3]);
                    *(u32x4*)(rowp + 32 * bj) = w; }
                asm volatile("" ::: "memory");
            }
    }
};
struct Epi5 {
    const float* bgate; bf16_t* gsc; bf16_t* gy; bf16_t* MG;
    __device__ __forceinline__ void operator()(const f32x4 (&acc)[2][2][4][2], const Unit& u, int wr, int wc, int fr, int fq) const {
        const int sub = u.sub;
        const int lc0 = wc * 32 + 8 * fq, lr0 = wr * 64 + fr;
        int toff = lr0 * 256 + lc0; asm volatile("" : "+v"(toff));
        if (sub == 0 || sub == 2) {
            const float* bp = bgate + (sub == 2 ? 1024 : 0) + u.pn * BM + lc0;
            f32x4 bb[2][2];
#pragma unroll
            for (int bj = 0; bj < 2; ++bj) { bb[bj][0] = *(const f32x4*)(bp + bj * HALF); bb[bj][1] = *(const f32x4*)(bp + bj * HALF + 4); }
#pragma unroll
            for (int ai = 0; ai < 2; ++ai)
#pragma unroll
                for (int m = 0; m < 4; ++m) {
#pragma unroll
                    for (int bj = 0; bj < 2; ++bj) { const f32x4 a0 = acc[ai][bj][m][0] + bb[bj][0], a1 = acc[ai][bj][m][1] + bb[bj][1];
                        u32x4 w; w.x = cvt_pk_bf16(sigmoidf_(a0[0]), sigmoidf_(a0[1])); w.y = cvt_pk_bf16(sigmoidf_(a0[2]), sigmoidf_(a0[3]));
                        w.z = cvt_pk_bf16(sigmoidf_(a1[0]), sigmoidf_(a1[1])); w.w = cvt_pk_bf16(sigmoidf_(a1[2]), sigmoidf_(a1[3]));
                        *(u32x4*)(gsc + toff + (ai * HALF + m * 16) * 256 + bj * HALF) = w; }
                    asm volatile("" ::: "memory"); }
        } else if (sub == 1) {
#pragma unroll
            for (int ai = 0; ai < 2; ++ai)
#pragma unroll
                for (int m = 0; m < 4; ++m) {
#pragma unroll
                    for (int bj = 0; bj < 2; ++bj) { const int o = toff + (ai * HALF + m * 16) * 256 + bj * HALF; const f32x4 a0 = acc[ai][bj][m][0], a1 = acc[ai][bj][m][1];
                        const u32x4 g = *(const u32x4*)(gsc + o); u32x4 w;
                        w.x = cvt_pk_bf16(bflo(g.x) * a0[0], bfhi(g.x) * a0[1]); w.y = cvt_pk_bf16(bflo(g.y) * a0[2], bfhi(g.y) * a0[3]);
                        w.z = cvt_pk_bf16(bflo(g.z) * a1[0], bfhi(g.z) * a1[1]); w.w = cvt_pk_bf16(bflo(g.w) * a1[2], bfhi(g.w) * a1[3]);
                        *(u32x4*)(gy + o) = w; }
                    asm volatile("" ::: "memory"); }
        } else {
            bf16_t* mg = MG + ((size_t)u.pm * BM + lr0) * DM + u.pn * BM + lc0;
#pragma unroll
            for (int ai = 0; ai < 2; ++ai)
#pragma unroll
                for (int m = 0; m < 4; ++m) {
#pragma unroll
                    for (int bj = 0; bj < 2; ++bj) { const int o = toff + (ai * HALF + m * 16) * 256 + bj * HALF; const f32x4 a0 = acc[ai][bj][m][0], a1 = acc[ai][bj][m][1];
                        const u32x4 g = *(const u32x4*)(gsc + o); const u32x4 y = *(const u32x4*)(gy + o); u32x4 w;
                        w.x = cvt_pk_bf16(bflo(y.x) + bflo(g.x) * a0[0], bfhi(y.x) + bfhi(g.x) * a0[1]); w.y = cvt_pk_bf16(bflo(y.y) + bflo(g.y) * a0[2], bfhi(y.y) + bfhi(g.y) * a0[3]);
                        w.z = cvt_pk_bf16(bflo(y.z) + bflo(g.z) * a1[0], bfhi(y.z) + bfhi(g.z) * a1[1]); w.w = cvt_pk_bf16(bflo(y.w) + bflo(g.w) * a1[2], bfhi(y.w) + bfhi(g.w) * a1[3]);
                        *(u32x4*)(mg + (ai * HALF + m * 16) * DM + bj * HALF) = w; }
                    asm volatile("" ::: "memory"); }
        }
    }
};
struct Epi6 {
    const float* x; float* out;
    __device__ __forceinline__ void operator()(const f32x4 (&acc)[2][2][4][2], const Unit& u, int wr, int wc, int fr, int fq) const {
        const int lc0 = u.pn * BM + wc * 32 + 8 * fq; const size_t row0 = (size_t)u.pm * BM + wr * 64 + fr;
#pragma unroll
        for (int ai = 0; ai < 2; ++ai)
#pragma unroll
            for (int m = 0; m < 4; ++m) { const size_t off = (row0 + ai * HALF + m * 16) * DM + lc0;
#pragma unroll
                for (int bj = 0; bj < 2; ++bj) { const f32x4 x0 = __builtin_nontemporal_load((const f32x4*)(x + off + bj * HALF)), x1 = __builtin_nontemporal_load((const f32x4*)(x + off + bj * HALF + 4));
                    __builtin_nontemporal_store(x0 + acc[ai][bj][m][0], (f32x4*)(out + off + bj * HALF)); __builtin_nontemporal_store(x1 + acc[ai][bj][m][1], (f32x4*)(out + off + bj * HALF + 4)); }
                asm volatile("" ::: "memory"); }
    }
};
}

#define XB_TMO      128
#define XB_XCNT(j)  (256  + 64 * (j))
#define XB_XSUB(j)  (1280 + 64 * (j))
#define XB_XGEN(j)  (2304 + 64 * (j))
#define XB_TOP      3328
#define XB_TOPGEN   3392
#define XCD_BAR_WORDS 3456
#define XB_SPIN_CAP (1u << 18)

__device__ __forceinline__ unsigned xb_ld(unsigned* p)              { return __hip_atomic_load(p, __ATOMIC_RELAXED, __HIP_MEMORY_SCOPE_AGENT); }
__device__ __forceinline__ unsigned xb_add(unsigned* p, unsigned v) { return __hip_atomic_fetch_add(p, v, __ATOMIC_RELAXED, __HIP_MEMORY_SCOPE_AGENT); }
__device__ __forceinline__ unsigned xb_xcc_id() { return (unsigned)__builtin_amdgcn_s_getreg((3 << 11) | 20) & 0xFu; }
#define XB_SPIN(cond, bar) do { unsigned _sp = 0; while (cond) { __builtin_amdgcn_s_sleep(1); \
    if ((++_sp & 255u) == 0u) { if (xb_ld(&(bar)[XB_TMO])) break; if (_sp > XB_SPIN_CAP) { atomicAdd(&(bar)[XB_TMO], 1u); break; } } } } while (0)

struct XcdBarrier {
    unsigned* bar; unsigned x;
    volatile LAS unsigned* st;
};

__device__ __forceinline__ XcdBarrier xcd_barrier_post(unsigned* bar, volatile LAS unsigned* st) {
    XcdBarrier b; b.bar = bar; b.x = xb_xcc_id(); b.st = st;
    if (threadIdx.x == 0) (void)xb_add(&bar[XB_XCNT(b.x)], 1u);
    return b;
}
__device__ __forceinline__ void xcd_barrier_complete(unsigned* bar, unsigned x, unsigned& nloc, unsigned& nx) {
    const unsigned G = gridDim.x * gridDim.y * gridDim.z;
    unsigned sum, cnt, mine, sp = 0u;
    for (;;) {
        sum = 0u; cnt = 0u; mine = 0u;
#pragma unroll
        for (unsigned j = 0; j < 16; ++j) { const unsigned c = xb_ld(&bar[XB_XCNT(j)]); sum += c; cnt += (c > 0u) ? 1u : 0u; mine = (j == x) ? c : mine; }
        if (sum == G) break;
        __builtin_amdgcn_s_sleep(1);
        if ((++sp & 255u) == 0u) { if (xb_ld(&bar[XB_TMO])) break; if (sp > XB_SPIN_CAP) { atomicAdd(&bar[XB_TMO], 1u); break; } }
    }
    nloc = mine > 0u ? mine : 1u; nx = cnt > 0u ? cnt : 1u;
}

__device__ __forceinline__ void xcd_barrier(const XcdBarrier& b) {
    asm volatile("s_waitcnt vmcnt(0)" ::: "memory");
    __syncthreads();
    if (threadIdx.x == 0) {
        unsigned* bar = b.bar;
        __builtin_amdgcn_s_waitcnt(0);
        unsigned nloc = b.st[0], nx = b.st[1];
        if (nloc == 0u) { xcd_barrier_complete(bar, b.x, nloc, nx); b.st[0] = nloc; b.st[1] = nx; }
        const unsigned old = xb_add(&bar[XB_XSUB(b.x)], 1u);
        const unsigned gen = old / nloc;
        if (old + 1u == (gen + 1u) * nloc) {
            __builtin_amdgcn_fence(__ATOMIC_RELEASE, "agent");
            asm volatile("s_waitcnt vmcnt(0)" ::: "memory");
            const unsigned og = xb_add(&bar[XB_TOP], 1u);
            const unsigned tg = og / nx;
            if (og + 1u == (tg + 1u) * nx) xb_add(&bar[XB_TOPGEN], 1u);
            else XB_SPIN(xb_ld(&bar[XB_TOPGEN]) == tg, bar);
            __builtin_amdgcn_fence(__ATOMIC_ACQUIRE, "agent");
            xb_add(&bar[XB_XGEN(b.x)], 1u);
            asm volatile("s_waitcnt vmcnt(0)" ::: "memory");
        } else {
            XB_SPIN(xb_ld(&bar[XB_XGEN(b.x)]) == gen, bar);
            __builtin_amdgcn_fence(__ATOMIC_ACQUIRE, "agent");
            asm volatile("s_waitcnt vmcnt(0)" ::: "memory");
        }
    }
    __syncthreads();
}

struct Args {
    const float *x, *norm_gain, *w_in, *b_gate, *conv_w, *a_log, *dt_bias, *dn_out_gain, *sb_q_gain, *sb_k_gain, *w_up_a, *w_up_b, *w_out;
    float* out; unsigned char* ws; int never; int pad;
};

__device__ __forceinline__ void p0_transpose_item(const float* W, int ldw, int src_col0, int k0, bf16_t* WT, int dst_row0, int dst_k0, LAS float* scr, int lane) {
#pragma unroll 8
    for (int i = 0; i < 32; ++i) { const int kk = 2 * i + (lane >> 5); scr[kk * 33 + (lane & 31)] = W[(size_t)(k0 + kk) * ldw + src_col0 + (lane & 31)]; }
    asm volatile("s_waitcnt lgkmcnt(0)" ::: "memory");
    const int c = lane & 7;
#pragma unroll
    for (int j = 0; j < 4; ++j) { const int n = (lane >> 3) + 8 * j; const LAS float* s = scr + (8 * c) * 33 + n;
        u32x4 o; o.x = cvt_pk_bf16(s[0 * 33], s[1 * 33]); o.y = cvt_pk_bf16(s[2 * 33], s[3 * 33]); o.z = cvt_pk_bf16(s[4 * 33], s[5 * 33]); o.w = cvt_pk_bf16(s[6 * 33], s[7 * 33]);
        *(u32x4*)(WT + (size_t)(dst_row0 + n) * 1024 + dst_k0 + 8 * c) = o; }
    asm volatile("s_waitcnt lgkmcnt(0)" ::: "memory");
}


#define MFMA16(a, b, c) __builtin_amdgcn_mfma_f32_16x16x32_bf16((a), (b), (c), 0, 0, 0)
__device__ __forceinline__ bf16x8 pack8(const f32x4 lo, const f32x4 hi) {
    u32x4 w;
    asm volatile("s_nop 7\n\ts_nop 7\n\ts_nop 3\n\tv_cvt_pk_bf16_f32 %0, %4, %5\n\tv_cvt_pk_bf16_f32 %1, %6, %7\n\tv_cvt_pk_bf16_f32 %2, %8, %9\n\tv_cvt_pk_bf16_f32 %3, %10, %11\n\ts_nop 1"
                 : "=&v"(w.x), "=&v"(w.y), "=&v"(w.z), "=&v"(w.w) : "v"(lo[0]), "v"(lo[1]), "v"(lo[2]), "v"(lo[3]), "v"(hi[0]), "v"(hi[1]), "v"(hi[2]), "v"(hi[3]));
    return __builtin_bit_cast(bf16x8, w);
}
#define LDS_FENCE() asm volatile("s_waitcnt lgkmcnt(0)" ::: "memory")

__device__ __forceinline__ void dn_rows_load(const bf16_t* QKVA, size_t row0, int col0, int lane, u32x4 (&r)[8]) {
    const bf16_t* rp = QKVA + (row0 + lane) * 1536 + col0;
#pragma unroll
    for (int grp = 0; grp < 8; ++grp) r[grp] = *(const u32x4*)(rp + 8 * grp);
}
__device__ __forceinline__ void dn_rows_to_lds(const u32x4 (&r)[8], LAS bf16_t* XT, int lane) {
#pragma unroll
    for (int grp = 0; grp < 8; ++grp) { const u32x4 w = r[grp]; LAS bf16_t* d = XT + (8 * grp) * 72 + lane;
        d[0 * 72] = (bf16_t)(w.x & 0xffffu); d[1 * 72] = (bf16_t)(w.x >> 16); d[2 * 72] = (bf16_t)(w.y & 0xffffu); d[3 * 72] = (bf16_t)(w.y >> 16);
        d[4 * 72] = (bf16_t)(w.z & 0xffffu); d[5 * 72] = (bf16_t)(w.z >> 16); d[6 * 72] = (bf16_t)(w.w & 0xffffu); d[7 * 72] = (bf16_t)(w.w >> 16); }
}

__device__ __forceinline__ void dn_prep(int task, LAS unsigned char* L, const bf16_t* QKVA, const float* BG, unsigned char* REC, bf16_t* UF, float* GE, int lane) {
    const int n = task & 31, h = (task >> 5) & 3, b = task >> 7;
    const size_t row0 = (size_t)b * SEQ + n * 64;
    LAS bf16_t* Mm = (LAS bf16_t*)L; LAS bf16_t* TT = (LAS bf16_t*)L;
    LAS bf16_t* XT = (LAS bf16_t*)(L + 8192);
    LAS float* GC = (LAS float*)(L + 17408); LAS float* BT = GC + 64; LAS float* DSC = GC + 128; LAS float* EGC = GC + 192;
    const int fr = lane & 15, fq = lane >> 4;
    unsigned char* rec = REC + (size_t)task * REC_BYTES;
    const float g = __hip_atomic_load(BG + (row0 + lane) * 8 + 4 + h, __ATOMIC_RELAXED, __HIP_MEMORY_SCOPE_AGENT), beta = __hip_atomic_load(BG + (row0 + lane) * 8 + h, __ATOMIC_RELAXED, __HIP_MEMORY_SCOPE_AGENT);
    float gc = g;
#pragma unroll
    for (int o = 1; o < 64; o <<= 1) { const float v = __shfl_up(gc, o); if (lane >= o) gc += v; }
    const float gl = __shfl(gc, 63);
    const float egc = __expf(gc);
    GC[lane] = gc; BT[lane] = beta; DSC[lane] = __expf(gl - gc); EGC[lane] = egc;
    if (lane == 0) GE[task] = __expf(gl);
    LDS_FENCE();
    bf16x8 kf[4][4];
#pragma unroll
    for (int mt = 0; mt < 4; ++mt)
#pragma unroll
        for (int ks = 0; ks < 4; ++ks) { const bf16_t* rp = QKVA + (row0 + 16 * mt + fr) * 1536 + 128 * h + 32 * ks + 4 * fq + 512;
            const u32x2 kl = *(const u32x2*)(rp), kh = *(const u32x2*)(rp + 16);
            u32x4 kw; kw.x = kl.x; kw.y = kl.y; kw.z = kh.x; kw.w = kh.y; kf[mt][ks] = __builtin_bit_cast(bf16x8, kw); }
    u32x4 qnx[4];
#pragma unroll
    for (int ks = 0; ks < 4; ++ks) { const bf16_t* rp = QKVA + (row0 + fr) * 1536 + 128 * h + 32 * ks + 4 * fq; const u32x2 ql = *(const u32x2*)(rp), qh = *(const u32x2*)(rp + 16); qnx[ks].x = ql.x; qnx[ks].y = ql.y; qnx[ks].z = qh.x; qnx[ks].w = qh.y; }
#pragma unroll
    for (int nt = 0; nt < 4; ++nt) { const float gci = GC[16 * nt + fr], sc = EGC[16 * nt + fr]; const int ic = 16 * nt + fr;
        bf16x8 qf[4]; u32x4 qw[4];
#pragma unroll
        for (int ks = 0; ks < 4; ++ks) qw[ks] = qnx[ks];
        if (nt < 3) {
#pragma unroll
            for (int ks = 0; ks < 4; ++ks) { const bf16_t* rp = QKVA + (row0 + 16 * (nt + 1) + fr) * 1536 + 128 * h + 32 * ks + 4 * fq; const u32x2 ql = *(const u32x2*)(rp), qh = *(const u32x2*)(rp + 16); qnx[ks].x = ql.x; qnx[ks].y = ql.y; qnx[ks].z = qh.x; qnx[ks].w = qh.y; } }
#pragma unroll
        for (int ks = 0; ks < 4; ++ks) { const u32x4 w = qw[ks]; qf[ks] = __builtin_bit_cast(bf16x8, w); u32x4 o;
            o.x = cvt_pk_safe(bflo(w.x) * sc, bfhi(w.x) * sc); o.y = cvt_pk_safe(bflo(w.y) * sc, bfhi(w.y) * sc); o.z = cvt_pk_safe(bflo(w.z) * sc, bfhi(w.z) * sc); o.w = cvt_pk_safe(bflo(w.w) * sc, bfhi(w.w) * sc);
            __builtin_nontemporal_store((u32x4)(o), (u32x4*)(rec + 16384 + ((ks * 4 + nt) * 64 + lane) * 16)); }
#pragma unroll
        for (int ks2 = 0; ks2 < 2; ++ks2) { f32x4 d0 = {0.f, 0.f, 0.f, 0.f}, d1 = {0.f, 0.f, 0.f, 0.f};
#pragma unroll
            for (int ks = 0; ks < 4; ++ks) { d0 = MFMA16(kf[2 * ks2][ks], qf[ks], d0); d1 = MFMA16(kf[2 * ks2 + 1][ks], qf[ks], d1); }
            const f32x4 gj0 = *(const LAS f32x4*)(GC + 32 * ks2 + 4 * fq), gj1 = *(const LAS f32x4*)(GC + 32 * ks2 + 16 + 4 * fq);
#pragma unroll
            for (int r = 0; r < 4; ++r) { const int j0 = 32 * ks2 + 4 * fq + r;
                d0[r] = (j0 <= ic) ? d0[r] * __expf(gci - gj0[r]) : 0.f; d1[r] = (j0 + 16 <= ic) ? d1[r] * __expf(gci - gj1[r]) : 0.f; }
            __builtin_nontemporal_store((bf16x8)(pack8(d0, d1)), (bf16x8*)(rec + 49152 + ((ks2 * 4 + nt) * 64 + lane) * 16)); }
        __builtin_amdgcn_sched_barrier(0); }
#pragma unroll
    for (int mt = 0; mt < 4; ++mt)
#pragma unroll
        for (int nt = 0; nt <= mt; ++nt) { f32x4 d = {0.f, 0.f, 0.f, 0.f};
#pragma unroll
            for (int ks = 0; ks < 4; ++ks) d = MFMA16(kf[mt][ks], kf[nt][ks], d);
            const float gcj = GC[16 * nt + fr]; const f32x4 gi = *(const LAS f32x4*)(GC + 16 * mt + 4 * fq), bi = *(const LAS f32x4*)(BT + 16 * mt + 4 * fq);
#pragma unroll
            for (int r = 0; r < 4; r += 2) { const int i = 16 * mt + 4 * fq + r, j = 16 * nt + fr; const float v0 = (j < i) ? bi[r] * d[r] * __expf(gi[r] - gcj) : 0.f, v1 = (j < i + 1) ? bi[r + 1] * d[r + 1] * __expf(gi[r + 1] - gcj) : 0.f;
                const unsigned w = cvt_pk_safe(v0, v1); Mm[i * 64 + j] = (bf16_t)(w & 0xffffu); Mm[(i + 1) * 64 + j] = (bf16_t)(w >> 16); } }
    __builtin_amdgcn_sched_barrier(0);
    u32x4 xr[8];
    dn_rows_load(QKVA, row0, 512 + 128 * h, lane, xr);
    LDS_FENCE();
    float t[64];
#define INV_ROWS(I0) _Pragma("unroll") for (int i = (I0); i < (I0) + 16; ++i) { float acc = (lane == i) ? 1.f : 0.f; \
        _Pragma("unroll") for (int jj = 0; jj < (i + 7) / 8; ++jj) { const u32x4 mv = *(const LAS u32x4*)(Mm + i * 64 + 8 * jj); \
            if (8 * jj + 0 < i) acc -= bflo(mv.x) * t[8 * jj + 0]; if (8 * jj + 1 < i) acc -= bfhi(mv.x) * t[8 * jj + 1]; if (8 * jj + 2 < i) acc -= bflo(mv.y) * t[8 * jj + 2]; if (8 * jj + 3 < i) acc -= bfhi(mv.y) * t[8 * jj + 3]; \
            if (8 * jj + 4 < i) acc -= bflo(mv.z) * t[8 * jj + 4]; if (8 * jj + 5 < i) acc -= bfhi(mv.z) * t[8 * jj + 5]; if (8 * jj + 6 < i) acc -= bflo(mv.w) * t[8 * jj + 6]; if (8 * jj + 7 < i) acc -= bfhi(mv.w) * t[8 * jj + 7]; } \
        t[i] = acc; }
    INV_ROWS(0) INV_ROWS(16) INV_ROWS(32) INV_ROWS(48)
#undef INV_ROWS
    LDS_FENCE();
    { const float s1 = beta * egc;
#pragma unroll
      for (int i = 0; i < 64; i += 2) { const unsigned w1 = cvt_pk_bf16(t[i] * s1, t[i + 1] * s1); TT[i * 64 + lane] = (bf16_t)(w1 & 0xffffu); TT[(i + 1) * 64 + lane] = (bf16_t)(w1 >> 16); } }
#pragma unroll
    for (int hf = 0; hf < 2; ++hf) {
        LDS_FENCE();
        dn_rows_to_lds(xr, XT, lane);
        if (hf == 0) dn_rows_load(QKVA, row0, 512 + 128 * h + 64, lane, xr); else dn_rows_load(QKVA, row0, 1024 + 128 * h, lane, xr);
        LDS_FENCE();
#pragma unroll
        for (int ks2 = 0; ks2 < 2; ++ks2) { const f32x4 s0 = *(const LAS f32x4*)(DSC + 32 * ks2 + 4 * fq), s1 = *(const LAS f32x4*)(DSC + 32 * ks2 + 16 + 4 * fq);
#pragma unroll
            for (int m4 = 0; m4 < 4; ++m4) { const LAS bf16_t* p = XT + (16 * m4 + fr) * 72 + 32 * ks2 + 4 * fq;
                const u32x2 lo = *(const LAS u32x2*)p, hi = *(const LAS u32x2*)(p + 16); u32x4 o;
                o.x = cvt_pk_bf16(bflo(lo.x) * s0[0], bfhi(lo.x) * s0[1]); o.y = cvt_pk_bf16(bflo(lo.y) * s0[2], bfhi(lo.y) * s0[3]);
                o.z = cvt_pk_bf16(bflo(hi.x) * s1[0], bfhi(hi.x) * s1[1]); o.w = cvt_pk_bf16(bflo(hi.y) * s1[2], bfhi(hi.y) * s1[3]);
                __builtin_nontemporal_store((u32x4)(o), (u32x4*)(rec + 32768 + ((ks2 * 8 + 4 * hf + m4) * 64 + lane) * 16)); } }
#pragma unroll
        for (int nt = 0; nt < 4; ++nt) { bf16x8 tb[2];
#pragma unroll
            for (int ks2 = 0; ks2 < 2; ++ks2) tb[ks2] = *(const LAS bf16x8*)(TT + (16 * nt + fr) * 64 + 32 * ks2 + 8 * fq);
            f32x4 d[4];
#pragma unroll
            for (int m4 = 0; m4 < 4; ++m4) { d[m4] = (f32x4){0.f, 0.f, 0.f, 0.f};
#pragma unroll
                for (int ks2 = 0; ks2 < 2; ++ks2) d[m4] = MFMA16(*(const LAS bf16x8*)(XT + (16 * m4 + fr) * 72 + 32 * ks2 + 8 * fq), tb[ks2], d[m4]); }
#pragma unroll
            for (int kl = 0; kl < 2; ++kl) __builtin_nontemporal_store((bf16x8)(pack8(-d[2 * kl], -d[2 * kl + 1])), (bf16x8*)(rec + (((2 * hf + kl) * 4 + nt) * 64 + lane) * 16)); }
    }
    LDS_FENCE();
    {
#pragma unroll
      for (int i = 0; i < 64; i += 2) { const unsigned w2 = cvt_pk_bf16(t[i] * beta, t[i + 1] * beta); TT[i * 64 + lane] = (bf16_t)(w2 & 0xffffu); TT[(i + 1) * 64 + lane] = (bf16_t)(w2 >> 16); } }
    bf16_t* uf = UF + (size_t)task * 8192;
#pragma unroll
    for (int hf = 0; hf < 2; ++hf) {
        LDS_FENCE();
        dn_rows_to_lds(xr, XT, lane);
        if (hf == 0) dn_rows_load(QKVA, row0, 1024 + 128 * h + 64, lane, xr);
        LDS_FENCE();
#pragma unroll
        for (int mt = 0; mt < 4; ++mt) { bf16x8 ta[2];
#pragma unroll
            for (int ks2 = 0; ks2 < 2; ++ks2) ta[ks2] = *(const LAS bf16x8*)(TT + (16 * mt + fr) * 64 + 32 * ks2 + 8 * fq);
#pragma unroll
            for (int n4 = 0; n4 < 4; ++n4) { f32x4 d = {0.f, 0.f, 0.f, 0.f};
#pragma unroll
                for (int ks2 = 0; ks2 < 2; ++ks2) d = MFMA16(ta[ks2], *(const LAS bf16x8*)(XT + (16 * n4 + fr) * 72 + 32 * ks2 + 8 * fq), d);
                u32x2 o; o.x = cvt_pk_safe(d[0], d[1]); o.y = cvt_pk_safe(d[2], d[3]); __builtin_nontemporal_store(o, (u32x2*)(uf + (((4 * hf + n4) * 4 + mt) * 64 + lane) * 4)); } }
    }
    LDS_FENCE();
}

#define SCAN_BAR() do { asm volatile("s_waitcnt lgkmcnt(0)" ::: "memory"); __builtin_amdgcn_s_barrier(); asm volatile("" ::: "memory"); } while (0)
__device__ __forceinline__ void dn_scan_wg(int unit, LAS unsigned char* lds, const unsigned char* REC, const bf16_t* UF, const float* GE, bf16_t* ORAW, int tid, int wave, int lane) {
    const int bh = unit, b = bh >> 2, h = bh & 3;
    const int fr = lane & 15, fq = lane >> 4;
    constexpr int IMG = REC_BYTES + 16384;
    if (wave >= 4) {
        const int lt = tid - 256; const unsigned char* rbase = REC + (size_t)(bh * 32) * REC_BYTES + lt * 16; const unsigned char* ubase = (const unsigned char*)UF + (size_t)(bh * 32) * 16384 + lt * 16;
        u32x4 A[18], B[18];
#define LREC(dst, r) do { const unsigned char* _p = rbase + (size_t)(r) * REC_BYTES; const unsigned char* _u = ubase + (size_t)(r) * 16384; \
            _Pragma("unroll") for (int _c = 0; _c < 14; ++_c) dst[_c] = __builtin_nontemporal_load((const u32x4*)(_p + _c * 4096)); _Pragma("unroll") for (int _c = 0; _c < 4; ++_c) dst[14 + _c] = __builtin_nontemporal_load((const u32x4*)(_u + _c * 4096)); } while (0)
#define SREC(src, buf) do { _Pragma("unroll") for (int _c = 0; _c < 18; ++_c) *(LAS u32x4*)(lds + (buf) * IMG + _c * 4096 + lt * 16) = src[_c]; } while (0)
        LREC(B, 0); LREC(A, 1);
        SREC(B, 0);
        SCAN_BAR();
        for (int n = 0; n < 32; n += 2) {
            if (n + 2 < 32) LREC(B, n + 2);
            SREC(A, (n + 1) & 1);
            SCAN_BAR();
            if (n + 3 < 32) LREC(A, n + 3);
            if (n + 2 < 32) SREC(B, (n + 2) & 1);
            SCAN_BAR();
        }
#undef LREC
#undef SREC
        return;
    }
    const int sl0 = 2 * wave;
    f32x4 S[2][8]; bf16x8 Sb[2][4];
#pragma unroll
    for (int cg = 0; cg < 2; ++cg) {
#pragma unroll
        for (int i = 0; i < 8; ++i) S[cg][i] = (f32x4){0.f, 0.f, 0.f, 0.f};
#pragma unroll
        for (int i = 0; i < 4; ++i) Sb[cg][i] = (bf16x8){0, 0, 0, 0, 0, 0, 0, 0}; }
    const float gev = GE[bh * 32 + (lane & 31)];
    float ge_all = gev; asm volatile("s_waitcnt vmcnt(0)" : "+v"(ge_all) :: "memory");
    SCAN_BAR();
    for (int n = 0; n < 32; ++n) {
        const LAS unsigned char* img = lds + (n & 1) * IMG;
        const LAS unsigned char* rec = img + lane * 16;
        const float ge = __shfl(ge_all, n);
        f32x4 vn[2][4];
#pragma unroll
        for (int cg = 0; cg < 2; ++cg)
#pragma unroll
            for (int mt = 0; mt < 4; ++mt) { const u32x2 uu = *(const LAS u32x2*)(img + REC_BYTES + (((sl0 + cg) * 4 + mt) * 64 + lane) * 8); vn[cg][mt] = (f32x4){bflo(uu.x), bfhi(uu.x), bflo(uu.y), bfhi(uu.y)}; }
        bf16x8 fa[4], fb[4];
#define LDF(dst, off) do { _Pragma("unroll") for (int _i = 0; _i < 4; ++_i) dst[_i] = *(const LAS bf16x8*)(rec + (off) + _i * 1024); } while (0)
#define MM4(accv, fr_, bsel) do { _Pragma("unroll") for (int _i = 0; _i < 4; ++_i) { accv[0][_i] = MFMA16(fr_[_i], bsel(0), accv[0][_i]); accv[1][_i] = MFMA16(fr_[_i], bsel(1), accv[1][_i]); } } while (0)
#define SBK0(cg) Sb[cg][0]
#define SBK1(cg) Sb[cg][1]
#define SBK2(cg) Sb[cg][2]
#define SBK3(cg) Sb[cg][3]
#define VBK0(cg) Vb[cg][0]
#define VBK1(cg) Vb[cg][1]
        LDF(fa, 0); LDF(fb, 4096);
        MM4(vn, fa, SBK0); LDF(fa, 8192);
        MM4(vn, fb, SBK1); LDF(fb, 12288);
        MM4(vn, fa, SBK2); LDF(fa, 16384);
        MM4(vn, fb, SBK3); LDF(fb, 16384 + 4096);
        bf16x8 Vb[2][2];
#pragma unroll
        for (int cg = 0; cg < 2; ++cg) { Vb[cg][0] = pack8(vn[cg][0], vn[cg][1]); Vb[cg][1] = pack8(vn[cg][2], vn[cg][3]); }
        f32x4 o[2][4];
#pragma unroll
        for (int cg = 0; cg < 2; ++cg)
#pragma unroll
            for (int mt = 0; mt < 4; ++mt) o[cg][mt] = (f32x4){0.f, 0.f, 0.f, 0.f};
        MM4(o, fa, SBK0);  LDF(fa, 16384 + 8192);
        MM4(o, fb, SBK1);  LDF(fb, 16384 + 12288);
        MM4(o, fa, SBK2);  LDF(fa, 49152);
        MM4(o, fb, SBK3);  LDF(fb, 49152 + 4096);
        MM4(o, fa, VBK0);  LDF(fa, 32768);
        MM4(o, fb, VBK1);  LDF(fb, 32768 + 4096);
#pragma unroll
        for (int i = 0; i < 4; ++i) { S[0][i] = MFMA16(fa[i], Vb[0][0], S[0][i] * ge); S[1][i] = MFMA16(fa[i], Vb[1][0], S[1][i] * ge); }
        LDF(fa, 32768 + 8192);
#pragma unroll
        for (int i = 0; i < 4; ++i) { S[0][4 + i] = MFMA16(fb[i], Vb[0][0], S[0][4 + i] * ge); S[1][4 + i] = MFMA16(fb[i], Vb[1][0], S[1][4 + i] * ge); }
        LDF(fb, 32768 + 12288);
#pragma unroll
        for (int cg = 0; cg < 2; ++cg) { bf16_t* op = ORAW + ((size_t)b * SEQ + 64 * n + 4 * fq) * 512 + 128 * h + 16 * (sl0 + cg) + fr;
#pragma unroll
            for (int mt = 0; mt < 4; ++mt) { const unsigned w0 = cvt_pk_safe(o[cg][mt][0], o[cg][mt][1]), w1 = cvt_pk_safe(o[cg][mt][2], o[cg][mt][3]);
                op[(16 * mt + 0) * 512] = (bf16_t)(w0 & 0xffffu); op[(16 * mt + 1) * 512] = (bf16_t)(w0 >> 16); op[(16 * mt + 2) * 512] = (bf16_t)(w1 & 0xffffu); op[(16 * mt + 3) * 512] = (bf16_t)(w1 >> 16); } }
#pragma unroll
        for (int i = 0; i < 4; ++i) { S[0][i] = MFMA16(fa[i], Vb[0][1], S[0][i]); S[1][i] = MFMA16(fa[i], Vb[1][1], S[1][i]); }
#pragma unroll
        for (int i = 0; i < 4; ++i) { S[0][4 + i] = MFMA16(fb[i], Vb[0][1], S[0][4 + i]); S[1][4 + i] = MFMA16(fb[i], Vb[1][1], S[1][4 + i]); }
#undef LDF
#undef MM4
#pragma unroll
        for (int cg = 0; cg < 2; ++cg)
#pragma unroll
            for (int ks = 0; ks < 4; ++ks) Sb[cg][ks] = pack8(S[cg][2 * ks], S[cg][2 * ks + 1]);
        SCAN_BAR();
    }
}

typedef float f32x16 __attribute__((ext_vector_type(16)));
#define MFMA32(a, b, c) __builtin_amdgcn_mfma_f32_32x32x16_bf16((a), (b), (c), 0, 0, 0)
__device__ __forceinline__ void attn_task(int task, bf16_t* P1, int lane) {
    const int qb = task & 63, h = (task >> 6) & 7, b = task >> 9;
    const int r32 = lane & 31, hi = lane >> 5;
    const int q0 = qb * 32, qi = q0 + r32;
    bf16_t* base = P1 + (size_t)b * SEQ * N1 + 64 * h;
    bf16x8 qf[4];
#pragma unroll
    for (int c = 0; c < 4; ++c) qf[c] = *(const bf16x8*)(base + (size_t)qi * N1 + 2048 + 16 * c + 8 * hi);
    bf16x8 ua0, ua1, ones;
#pragma unroll
    for (int e = 0; e < 8; ++e) { const int key0 = 8 * (e >> 2) + 4 * hi + (e & 3); ua0[e] = (key0 > r32) ? (short)0x3F80 : (short)0; ua1[e] = (16 + key0 > r32) ? (short)0x3F80 : (short)0; ones[e] = (short)0x3F80; }
    f32x16 o[2];
#pragma unroll
    for (int i = 0; i < 16; ++i) { o[0][i] = 0.f; o[1][i] = 0.f; }
    float R = 0.f;
    const int ktd = q0 >> 6;
    bf16x8 kn[2][4];
#define LOAD_KV(KT) do { _Pragma("unroll") for (int mt = 0; mt < 2; ++mt) _Pragma("unroll") for (int c = 0; c < 4; ++c) \
        kn[mt][c] = *(const bf16x8*)(base + (size_t)((KT) * 64 + 32 * mt + r32) * N1 + 2560 + 16 * c + 8 * hi); } while (0)
    LOAD_KV(ktd);
    for (int kt = ktd; kt >= 0; --kt) {
        const int k0 = kt * 64; const bool diag = (kt == ktd);
        bf16x8 kf[2][4], vf[2][4];
#pragma unroll
        for (int mt = 0; mt < 2; ++mt)
#pragma unroll
            for (int c = 0; c < 4; ++c) { kf[mt][c] = kn[mt][c]; vf[mt][c] = *(const bf16x8*)(base + (size_t)((32 * mt + r32) * 32 + kt) * N1 + 3072 + 16 * c + 8 * hi); }
        if (kt > 0) LOAD_KV(kt - 1);
        f32x16 p[2];
#pragma unroll
        for (int i = 0; i < 16; ++i) { p[0][i] = 0.f; p[1][i] = 0.f; }
#pragma unroll
        for (int c = 0; c < 4; ++c) { p[0] = MFMA32(kf[0][c], qf[c], p[0]); p[1] = MFMA32(kf[1][c], qf[c], p[1]); }
        f32x16 lk[2]; float rs = 0.f;
#pragma unroll
        for (int mt = 0; mt < 2; ++mt)
#pragma unroll
            for (int r = 0; r < 16; ++r) { const int key = k0 + 32 * mt + (r & 3) + 8 * (r >> 2) + 4 * hi; const float z = p[mt][r];
                const float e = __builtin_amdgcn_exp2f(-fabsf(z)); const float sp = fmaxf(z, 0.f) + __builtin_amdgcn_logf(1.0f + e);
                const bool valid = !diag || key < qi; const float l = valid ? -sp : 0.f; lk[mt][r] = l; p[mt][r] = z - sp; rs += l; }
        bf16x8 lh[4];
#pragma unroll
        for (int kc = 0; kc < 4; ++kc) { u32x4 wh;
#pragma unroll
            for (int e2 = 0; e2 < 4; ++e2) wh[e2] = cvt_pk_bf16(lk[kc >> 1][8 * (kc & 1) + 2 * e2], lk[kc >> 1][8 * (kc & 1) + 2 * e2 + 1]);
            lh[kc] = __builtin_bit_cast(bf16x8, wh); }
        f32x16 cum[2];
#pragma unroll
        for (int i = 0; i < 16; ++i) { cum[0][i] = 0.f; cum[1][i] = 0.f; }
        cum[0] = MFMA32(ua0, lh[0], cum[0]); cum[0] = MFMA32(ua1, lh[1], cum[0]); cum[0] = MFMA32(ones, lh[2], cum[0]); cum[0] = MFMA32(ones, lh[3], cum[0]);
        cum[1] = MFMA32(ua0, lh[2], cum[1]); cum[1] = MFMA32(ua1, lh[3], cum[1]);
        bf16x8 pb[4];
#pragma unroll
        for (int kc = 0; kc < 4; ++kc) { u32x4 w; const int mt = kc >> 1;
#pragma unroll
            for (int e2 = 0; e2 < 4; ++e2) { const int ra = 8 * (kc & 1) + 2 * e2, rb = ra + 1;
                const int keya = k0 + 32 * mt + (ra & 3) + 8 * (ra >> 2) + 4 * hi, keyb = k0 + 32 * mt + (rb & 3) + 8 * (rb >> 2) + 4 * hi;
                float wa = __builtin_amdgcn_exp2f(p[mt][ra] + cum[mt][ra] + R), wb = __builtin_amdgcn_exp2f(p[mt][rb] + cum[mt][rb] + R);
                wa = (!diag || keya < qi) ? wa : 0.f; wb = (!diag || keyb < qi) ? wb : 0.f;
                w[e2] = cvt_pk_bf16(wa, wb); }
            pb[kc] = __builtin_bit_cast(bf16x8, w); }
#pragma unroll
        for (int kc = 0; kc < 4; ++kc) { o[0] = MFMA32(vf[0][kc], pb[kc], o[0]); o[1] = MFMA32(vf[1][kc], pb[kc], o[1]); }
        rs += __shfl_xor(rs, 32); R += rs;
        if (__ballot(R >= -150.f) == 0ull) break;
    }
#undef LOAD_KV
    bf16_t* qrow = base + (size_t)qi * N1 + 2048; const bf16_t* zrow = base + (size_t)qi * N1 + 3584;
#pragma unroll
    for (int mt = 0; mt < 2; ++mt)
#pragma unroll
        for (int g = 0; g < 4; ++g) { const int d = 32 * mt + 8 * g + 4 * hi; const u32x2 zz = *(const u32x2*)(zrow + d);
            const float v0 = o[mt][4 * g] * bflo(zz.x), v1 = o[mt][4 * g + 1] * bfhi(zz.x), v2 = o[mt][4 * g + 2] * bflo(zz.y), v3 = o[mt][4 * g + 3] * bfhi(zz.y);
            u32x2 w; w.x = cvt_pk_bf16(v0, v1); w.y = cvt_pk_bf16(v2, v3); *(u32x2*)(qrow + d) = w; }
}
__device__ __forceinline__ void attn_queue(unsigned* ctr, bf16_t* P1, int lane) {
    for (;;) { unsigned tk = 0; if (lane == 0) tk = atomicAdd(ctr, 1u); tk = (unsigned)__builtin_amdgcn_readfirstlane((int)tk); if (tk >= 16u * 8u * 64u) break; attn_task((int)tk, P1, lane); }
}

__global__ void __launch_bounds__(512, 2) fwd(Args a) {
    extern __shared__ __attribute__((aligned(16))) unsigned char lds_raw[];
    LAS unsigned char* lds = (LAS unsigned char*)lds_raw;
    cg::grid_group grid = cg::this_grid();
    const int tid = threadIdx.x, lane = tid & 63, wave = __builtin_amdgcn_readfirstlane(tid >> 6);
    const int G = gridDim.x, gw = blockIdx.x * NWAVES + wave, NGW = G * NWAVES;
    unsigned char* ws = a.ws;
    if (tid < 64) ((LAS unsigned*)(lds + 147456))[tid] = 0u;
    __syncthreads();
    XcdBarrier bar = xcd_barrier_post((unsigned*)(ws + WS_BAR), (volatile LAS unsigned*)(lds + 147456));
    bf16_t* W1T = (bf16_t*)(ws + WS_W1T); bf16_t* WGT = (bf16_t*)(ws + WS_WGT); bf16_t* WUPT = (bf16_t*)(ws + WS_WUPT); bf16_t* WOT = (bf16_t*)(ws + WS_WOT);
    float* BG = (float*)(ws + WS_BG); bf16_t* XN = (bf16_t*)(ws + WS_XN); bf16_t* P1 = (bf16_t*)(ws + WS_P1);
    bf16_t* QKVA = (bf16_t*)(ws + WS_QKVA); bf16_t* ORAW = (bf16_t*)(ws + WS_ORAW); bf16_t* MG = (bf16_t*)(ws + WS_MG);
    bf16_t* GSC = (bf16_t*)(ws + WS_GSC) + (size_t)blockIdx.x * 65536; bf16_t* GY = (bf16_t*)((unsigned char*)a.out + OUT_GY) + (size_t)blockIdx.x * 65536;

    {
        if (blockIdx.x == 0 && tid == 0) *(unsigned*)(ws + WS_CTL) = 0u;
        LAS float* scr = (LAS float*)(lds + wave * 8704);
        LAS float* W8T = (LAS float*)(lds + 69632);
        for (int i = 0; i < 16; ++i) { const int idx = tid + 512 * i, c = idx & 7, d = idx >> 3; W8T[c * 1024 + d] = a.w_in[(size_t)d * PROJ + 2048 + c]; }
        for (int it = gw; it < 4096; it += NGW) {
            int r = it;
            if (r < 2048) { const int kb = r >> 7, nb = r & 127, pn = nb >> 3, p0 = 32 * (nb & 7); const int logical = pn * 256 + 64 * ((p0 >> 5) & 3) + 32 * (p0 >> 7);
                const int src = logical < 2048 ? logical : logical + 8;
                p0_transpose_item(a.w_in, PROJ, src, 64 * kb, W1T, 32 * nb, 64 * kb, scr, lane); continue; }
            r -= 2048;
            if (r < 1024) { const int kb = r >> 6, nb = r & 63; p0_transpose_item(a.w_in, PROJ, 4104 + 32 * nb, 64 * kb, WGT, 32 * nb, 64 * kb, scr, lane); continue; }
            r -= 1024;
            if (r < 256) { const int kb = r >> 5, nb = r & 31; p0_transpose_item(a.w_up_a, DM, 32 * nb, 64 * kb, WUPT, 32 * nb, 64 * kb, scr, lane); continue; }
            r -= 256;
            if (r < 256) { const int kb = r >> 5, nb = r & 31; p0_transpose_item(a.w_up_b, DM, 32 * nb, 64 * kb, WUPT, 32 * nb, 512 + 64 * kb, scr, lane); continue; }
            r -= 256;
            { const int kb = r >> 5, nb = r & 31; p0_transpose_item(a.w_out, DM, 32 * nb, 64 * kb, WOT, 32 * nb, 64 * kb, scr, lane); }
        }
        __syncthreads();
        f32x4 gv[4];
#pragma unroll
        for (int j = 0; j < 4; ++j) gv[j] = ((const f32x4*)a.norm_gain)[lane + 64 * j];
        for (int rb = gw * 4; rb < M; rb += NGW * 4) {
            f32x4 v[4][4]; float ss[4];
#pragma unroll
            for (int q = 0; q < 4; ++q) { const f32x4* xr = (const f32x4*)(a.x + (size_t)(rb + q) * DM) + lane; ss[q] = 0.f;
#pragma unroll
                for (int j = 0; j < 4; ++j) { v[q][j] = __builtin_nontemporal_load(xr + 64 * j); } }
#pragma unroll
            for (int q = 0; q < 4; ++q)
#pragma unroll
                for (int j = 0; j < 4; ++j) ss[q] += (v[q][j][0] * v[q][j][0] + v[q][j][1] * v[q][j][1]) + (v[q][j][2] * v[q][j][2] + v[q][j][3] * v[q][j][3]);
#pragma unroll
            for (int o = 1; o < 64; o <<= 1) {
#pragma unroll
                for (int q = 0; q < 4; ++q) ss[q] += __shfl_xor(ss[q], o); }
            float bg[4][8];
#pragma unroll
            for (int q = 0; q < 4; ++q) { const float rstd = __builtin_amdgcn_rsqf(ss[q] * (1.0f / DM) + EPS);
#pragma unroll
                for (int c = 0; c < 8; ++c) bg[q][c] = 0.f;
                u32x2* o8 = (u32x2*)(XN + (size_t)(rb + q) * DM) + lane;
#pragma unroll
                for (int j = 0; j < 4; ++j) { v[q][j] = v[q][j] * rstd * gv[j]; u32x2 w; w.x = cvt_pk_bf16(v[q][j][0], v[q][j][1]); w.y = cvt_pk_bf16(v[q][j][2], v[q][j][3]); o8[64 * j] = w; } }
#pragma unroll
            for (int j = 0; j < 4; ++j)
#pragma unroll
                for (int c = 0; c < 8; ++c) { const f32x4 wv = *(const LAS f32x4*)(W8T + c * 1024 + 4 * lane + 256 * j);
#pragma unroll
                    for (int q = 0; q < 4; ++q) bg[q][c] += (v[q][j][0] * wv[0] + v[q][j][1] * wv[1]) + (v[q][j][2] * wv[2] + v[q][j][3] * wv[3]); }
#pragma unroll
            for (int q = 0; q < 4; ++q) { const bool b0 = lane & 1, b1 = lane & 2, b2 = lane & 4;
                float t4[4];
#pragma unroll
                for (int c = 0; c < 4; ++c) { const float snd = b0 ? bg[q][c] : bg[q][c + 4], keep = b0 ? bg[q][c + 4] : bg[q][c]; t4[c] = keep + __shfl_xor(snd, 1); }
                float t2[2];
#pragma unroll
                for (int c = 0; c < 2; ++c) { const float snd = b1 ? t4[c] : t4[c + 2], keep = b1 ? t4[c + 2] : t4[c]; t2[c] = keep + __shfl_xor(snd, 2); }
                float t1; { const float snd = b2 ? t2[0] : t2[1], keep = b2 ? t2[1] : t2[0]; t1 = keep + __shfl_xor(snd, 4); }
                t1 += __shfl_xor(t1, 8); t1 += __shfl_xor(t1, 16); t1 += __shfl_xor(t1, 32);
                if (lane < 8) BG[(size_t)(rb + q) * 8 + (b0 ? 4 : 0) + (b1 ? 2 : 0) + (b2 ? 1 : 0)] = t1; }
        }
    }
    if (a.never) grid.sync();
    xcd_barrier(bar);

    {
        pg8::SchedPlain S{(const char*)XN, (const char*)W1T, 16, 128, 16, G, (int)blockIdx.x};
        pg8::Epi1 E{P1, a.sb_q_gain, a.sb_k_gain};
        pg8::gemm_phase<pg8::Epi1, pg8::SchedPlain>(lds, S, E);
    }
    xcd_barrier(bar);

    {
        for (int run = gw; run < M / 16; run += NGW) {
            const int t0 = run * 16; const bool seq_start = (t0 % SEQ) == 0;
#pragma unroll
            for (int g = 0; g < 3; ++g) {
                float cw[4][8];
#pragma unroll
                for (int tp = 0; tp < 4; ++tp) { const f32x4 c0 = *(const f32x4*)(a.conv_w + tp * 1536 + 512 * g + 8 * lane), c1 = *(const f32x4*)(a.conv_w + tp * 1536 + 512 * g + 8 * lane + 4);
#pragma unroll
                    for (int e = 0; e < 4; ++e) { cw[tp][e] = c0[e]; cw[tp][4 + e] = c1[e]; } }
                u32x4 rows[19];
#pragma unroll
                for (int k = 0; k < 19; ++k) rows[k] = (k < 3 && seq_start) ? (u32x4){0u, 0u, 0u, 0u} : __builtin_nontemporal_load((const u32x4*)(P1 + (size_t)(t0 - 3 + k) * N1 + 512 * g + 8 * lane));
#pragma unroll
                for (int tt = 0; tt < 16; ++tt) {
                    float val[8]; float ss = 0.f;
#pragma unroll
                    for (int e2 = 0; e2 < 4; ++e2) {
                        const unsigned w0 = rows[tt][e2], w1 = rows[tt + 1][e2], w2 = rows[tt + 2][e2], w3 = rows[tt + 3][e2];
                        float lo = cw[0][2 * e2] * bflo(w0) + cw[1][2 * e2] * bflo(w1) + cw[2][2 * e2] * bflo(w2) + cw[3][2 * e2] * bflo(w3);
                        float hi = cw[0][2 * e2 + 1] * bfhi(w0) + cw[1][2 * e2 + 1] * bfhi(w1) + cw[2][2 * e2 + 1] * bfhi(w2) + cw[3][2 * e2 + 1] * bfhi(w3);
                        lo = lo * sigmoidf_(lo); hi = hi * sigmoidf_(hi);
                        val[2 * e2] = lo; val[2 * e2 + 1] = hi; ss += lo * lo + hi * hi;
                    }
                    float sc = 1.f;
                    if (g < 2) { ss = red16(ss); sc = __builtin_amdgcn_rsqf(ss + EPS); if (g == 0) sc *= 0.08838834764831845f; }
                    u32x4 w; w.x = cvt_pk_bf16(val[0] * sc, val[1] * sc); w.y = cvt_pk_bf16(val[2] * sc, val[3] * sc); w.z = cvt_pk_bf16(val[4] * sc, val[5] * sc); w.w = cvt_pk_bf16(val[6] * sc, val[7] * sc);
                    *(u32x4*)(QKVA + (size_t)(t0 + tt) * 1536 + 512 * g + 8 * lane) = w;
                }
            }
            { const int tk = lane >> 2, hh = lane & 3; float* bgp = BG + (size_t)(t0 + tk) * 8; const float blv = bgp[hh], dlv = bgp[4 + hh];
              const float beta = sigmoidf_(blv); const float xx = dlv + a.dt_bias[hh]; const float sp = fmaxf(xx, 0.f) + log1pf(expf(-fabsf(xx)));
              const float gg = -expf(a.a_log[hh]) * sp; bgp[hh] = beta; bgp[4 + hh] = gg; }
        }
    }
    unsigned* actr = (unsigned*)(ws + WS_CTL);
    unsigned char* REC = (unsigned char*)a.out + OUT_REC; bf16_t* UF = (bf16_t*)(ws + WS_UF); float* GE = (float*)(ws + WS_GE);
    if (G == 256) { asm volatile("s_waitcnt vmcnt(0)" ::: "memory"); __syncthreads();
        const int bb = blockIdx.x >> 4, n0 = 2 * (blockIdx.x & 15); dn_prep((bb * 4 + (wave & 3)) * 32 + n0 + (wave >> 2), lds + wave * 18432, QKVA, BG, REC, UF, GE, lane); }
    else { xcd_barrier(bar); for (int task = blockIdx.x * 8 + wave; task < 2048; task += G * 8) dn_prep(task, lds + wave * 18432, QKVA, BG, REC, UF, GE, lane); }
    xcd_barrier(bar);

    if (G == 256) { if (((blockIdx.x >> 3) & 3) == 0) dn_scan_wg((blockIdx.x >> 5) * 8 + (blockIdx.x & 7), lds, REC, UF, GE, ORAW, tid, wave, lane); }
    else { for (int bh = blockIdx.x; bh < 64; bh += G) dn_scan_wg(bh, lds, REC, UF, GE, ORAW, tid, wave, lane); }
    attn_queue(actr, P1, lane);
    xcd_barrier(bar);

    {
        int lane4 = lane; asm volatile("" : "+v"(lane4));
        f32x4 g0 = *(const f32x4*)(a.dn_out_gain + ((8 * lane4) & 127)), g1 = *(const f32x4*)(a.dn_out_gain + ((8 * lane4) & 127) + 4);
        for (int rb = gw * 4; rb < M; rb += NGW * 4) {
            u32x4 ov4[4], zv4[4];
#pragma unroll
            for (int q = 0; q < 4; ++q) { ov4[q] = __builtin_nontemporal_load((const u32x4*)(ORAW + (size_t)(rb + q) * 512 + 8 * lane)); zv4[q] = __builtin_nontemporal_load((const u32x4*)(P1 + (size_t)(rb + q) * N1 + 1536 + 8 * lane)); }
#pragma unroll
            for (int q = 0; q < 4; ++q) { const u32x4 ov = ov4[q], zv = zv4[q];
                float v[8] = {bflo(ov.x), bfhi(ov.x), bflo(ov.y), bfhi(ov.y), bflo(ov.z), bfhi(ov.z), bflo(ov.w), bfhi(ov.w)};
                const float z[8] = {bflo(zv.x), bfhi(zv.x), bflo(zv.y), bfhi(zv.y), bflo(zv.z), bfhi(zv.z), bflo(zv.w), bfhi(zv.w)};
                float ss = 0.f;
#pragma unroll
                for (int i = 0; i < 8; ++i) ss += v[i] * v[i];
                ss = red16(ss);
                const float rs = __builtin_amdgcn_rsqf(ss * (1.0f / 128.0f) + EPS);
#pragma unroll
                for (int i = 0; i < 8; ++i) v[i] = v[i] * rs * (i < 4 ? g0[i & 3] : g1[i & 3]) * z[i];
                u32x4 w; w.x = cvt_pk_bf16(v[0], v[1]); w.y = cvt_pk_bf16(v[2], v[3]); w.z = cvt_pk_bf16(v[4], v[5]); w.w = cvt_pk_bf16(v[6], v[7]);
                *(u32x4*)(P1 + (size_t)(rb + q) * N1 + 1536 + 8 * lane) = w; }
        }
    }
    xcd_barrier(bar);

    {
        pg8::SchedP5 S{(const char*)XN, (const char*)WGT, (const char*)P1, (const char*)WUPT, G, (int)blockIdx.x};
        pg8::Epi5 E{a.b_gate, GSC, GY, MG};
        pg8::gemm_phase<pg8::Epi5, pg8::SchedP5>(lds, S, E);
    }
    xcd_barrier(bar);

    {
        pg8::SchedPlain S{(const char*)MG, (const char*)WOT, 16, 128, 4, G, (int)blockIdx.x};
        pg8::Epi6 E{a.x, a.out};
        pg8::gemm_phase<pg8::Epi6, pg8::SchedPlain>(lds, S, E);
    }
}

extern "C" void kernel_launch(void* const* d_in, const int* in_sizes, int n_in, void* d_out, int out_size, void* d_ws, size_t ws_size, hipStream_t stream) {
    static int grid = 0;
    if (grid == 0) {
        if (n_in != 13 || out_size != M * DM || ws_size < WS_END) { fprintf(stderr, "kernel_launch: unexpected problem (n_in %d out %d ws %zu)\n", n_in, out_size, ws_size); grid = -1; return; }
        int dev = 0, cus = 0, per_cu = 0;
        (void)hipGetDevice(&dev); (void)hipDeviceGetAttribute(&cus, hipDeviceAttributeMultiprocessorCount, dev);
        (void)hipFuncSetAttribute((const void*)fwd, hipFuncAttributeMaxDynamicSharedMemorySize, LDS_BYTES);
        (void)hipOccupancyMaxActiveBlocksPerMultiprocessor(&per_cu, (const void*)fwd, NWAVES * 64, LDS_BYTES);
        if (per_cu < 1) fprintf(stderr, "kernel_launch: occupancy query says %d blocks per CU\n", per_cu);
        grid = cus;
    }
    if (grid < 0) return;
    (void)hipMemsetAsync((unsigned char*)d_ws + WS_BAR, 0, XCD_BAR_WORDS * 4, stream);
    Args a{};
    a.x = (const float*)d_in[0]; a.norm_gain = (const float*)d_in[1]; a.w_in = (const float*)d_in[2]; a.b_gate = (const float*)d_in[3]; a.conv_w = (const float*)d_in[4];
    a.a_log = (const float*)d_in[5]; a.dt_bias = (const float*)d_in[6]; a.dn_out_gain = (const float*)d_in[7]; a.sb_q_gain = (const float*)d_in[8]; a.sb_k_gain = (const float*)d_in[9];
    a.w_up_a = (const float*)d_in[10]; a.w_up_b = (const float*)d_in[11]; a.w_out = (const float*)d_in[12];
    a.out = (float*)d_out; a.ws = (unsigned char*)d_ws;
    void* args[] = {&a};
    hipError_t e = hipLaunchCooperativeKernel((const void*)fwd, dim3(grid), dim3(NWAVES * 64), args, LDS_BYTES, stream);
    if (e != hipSuccess) fprintf(stderr, "kernel_launch: cooperative launch failed: %s (grid %d)\n", hipGetErrorString(e), grid);
}
```

```cpp
#include <hip/hip_runtime.h>
#include <hip/hip_cooperative_groups.h>
#include <cstdio>
#include <cstdint>
namespace cg = cooperative_groups;

#define LAS __attribute__((address_space(3)))
typedef unsigned short bf16_t;
typedef short bf16x8 __attribute__((ext_vector_type(8)));
typedef float f32x4 __attribute__((ext_vector_type(4)));
typedef unsigned u32x4 __attribute__((ext_vector_type(4)));
typedef unsigned u32x2 __attribute__((ext_vector_type(2)));
typedef __bf16 bf16x2_t __attribute__((ext_vector_type(2)));

constexpr int M = 32768, DM = 1024, SEQ = 2048;
constexpr int N1 = 4096;
constexpr int PROJ = 6152;
constexpr float EPS = 1e-6f;
constexpr float QSCALE = 0.125f * 1.4426950408889634f;
constexpr int NWAVES = 8;
constexpr size_t MiB = (size_t)1 << 20;
constexpr size_t WS_CTL = 0, WS_W1T = 1 * MiB, WS_WGT = 9 * MiB, WS_WUPT = 13 * MiB, WS_WOT = 15 * MiB, WS_BG = 17 * MiB, WS_XN = 18 * MiB, WS_P1 = 82 * MiB,
                 WS_QKVA = 338 * MiB, WS_ORAW = 434 * MiB, WS_UF = 466 * MiB, WS_END = 498 * MiB;
constexpr size_t WS_GE = 4096;
constexpr size_t WS_BAR = 65536;
constexpr size_t WS_MG = WS_QKVA;
constexpr size_t WS_GSC = WS_ORAW;
constexpr size_t OUT_REC = 0, OUT_GY = 64 * MiB;
constexpr int REC_BYTES = 57344;
constexpr int LDS_BYTES = 147456 + 256;

typedef float f32x2_t __attribute__((ext_vector_type(2)));
__device__ __forceinline__ unsigned cvt_pk_bf16(float lo, float hi) { unsigned r; asm volatile("s_nop 1\n\tv_cvt_pk_bf16_f32 %0, %1, %2\n\ts_nop 1" : "=v"(r) : "v"(lo), "v"(hi)); return r; }
__device__ __forceinline__ unsigned cvt_pk_safe(float lo, float hi) { unsigned r; asm volatile("s_nop 7\n\ts_nop 7\n\ts_nop 3\n\tv_cvt_pk_bf16_f32 %0, %1, %2\n\ts_nop 1" : "=v"(r) : "v"(lo), "v"(hi)); return r; }
__device__ __forceinline__ unsigned cvt_pk_v(float lo, float hi) { const f32x2_t v = {lo, hi}; const bf16x2_t b = __builtin_convertvector(v, bf16x2_t); return __builtin_bit_cast(unsigned, b); }
__device__ __forceinline__ float bflo(unsigned w) { return __uint_as_float(w << 16); }
__device__ __forceinline__ float bfhi(unsigned w) { return __uint_as_float(w & 0xffff0000u); }
__device__ __forceinline__ float sigmoidf_(float v) { return __builtin_amdgcn_rcpf(1.0f + __expf(-v)); }
__device__ __forceinline__ float wave_sum(float v) {
#pragma unroll
    for (int o = 1; o < 64; o <<= 1) v += __shfl_xor(v, o);
    return v;
}
#define DPP_ADD(v, CTRL) v += __builtin_bit_cast(float, __builtin_amdgcn_update_dpp(0, __builtin_bit_cast(int, v), CTRL, 0xF, 0xF, true))
__device__ __forceinline__ float red16(float v) {
    DPP_ADD(v, 0xB1); DPP_ADD(v, 0x4E); DPP_ADD(v, 0x141); DPP_ADD(v, 0x140);
    return v;
}

namespace pg8 {
constexpr int BM = 256, BK = 64, HALF = 128, HTB = HALF * BK * 2, NXCD = 8, WGM = 8;
constexpr int PITCH = 2048;
__device__ __forceinline__ int lds_byte(int r, int c) { const int st = (r >> 4) * 2 + (c >> 5), rr = r & 15, cc = c & 31, ob = rr * 64 + cc * 2; return st * 1024 + (ob ^ (((ob >> 9) & 1) << 5)); }
__device__ __forceinline__ void stage_rc(int b, int& R, int& C) { const int st = b / 1024, sb = b % 1024, swz = sb ^ (((sb >> 9) & 1) << 5); R = (st >> 1) * 16 + swz / 64; C = (st & 1) * 32 + (swz % 64) / 2; }
__device__ __forceinline__ int perm32(int rho) { const int n = rho >> 4, i = rho & 15; return 8 * (i >> 2) + 4 * n + (i & 3); }

struct Unit { const char* A; const char* B; int nt, pm, pn, sub, ap; };

__device__ __forceinline__ void tile_of(int L, int nM, int nN, int& pm, int& pn) {
    const int nwg = nM * nN; int wgid = L;
    { const int q = nwg / NXCD, r = nwg % NXCD, xcd = wgid % NXCD, off = wgid / NXCD; wgid = (xcd < r ? xcd * (q + 1) : r * (q + 1) + (xcd - r) * q) + off; }
    const int nig = WGM * nN, gid = wgid / nig, fm = gid * WGM, gsz = (nM - fm) < WGM ? (nM - fm) : WGM;
    pm = fm + ((wgid % nig) % gsz); pn = (wgid % nig) / gsz;
}
struct SchedPlain {
    const char* A; const char* B; int nt, nM, nN, G, c;
    __device__ __forceinline__ bool next(int i, Unit& u) const {
        const long L = (long)i * G + c; if (L >= (long)nM * nN) return false;
        tile_of((int)L, nM, nN, u.pm, u.pn);
        u.A = A + (size_t)u.pm * BM * PITCH; u.B = B + (size_t)u.pn * BM * PITCH; u.nt = nt; u.sub = 0; u.ap = 0; return true;
    }
};
struct SchedP5 {
    const char* XN; const char* WG; const char* P1; const char* WUP; int G, c;
    __device__ __forceinline__ bool next(int i, Unit& u) const {
        const int ti = i >> 2, sub = i & 3; const long L = (long)ti * G + c; if (L >= 128 * 4) return false;
        tile_of((int)L, 128, 4, u.pm, u.pn); u.sub = sub;
        if (sub == 0)      { u.A = XN + (size_t)u.pm * BM * PITCH;            u.B = WG + (size_t)(u.pn * BM) * PITCH;         u.nt = 16; u.ap = 0; }
        else if (sub == 1) { u.A = P1 + (size_t)u.pm * BM * 8192 + 1536 * 2; u.B = WUP + (size_t)(u.pn * BM) * PITCH;        u.nt = 8;  u.ap = 1; }
        else if (sub == 2) { u.A = XN + (size_t)u.pm * BM * PITCH;            u.B = WG + (size_t)(1024 + u.pn * BM) * PITCH;  u.nt = 16; u.ap = 0; }
        else               { u.A = P1 + (size_t)u.pm * BM * 8192 + 2048 * 2; u.B = WUP + (size_t)(u.pn * BM) * PITCH + 1024; u.nt = 8;  u.ap = 1; }
        return true;
    }
};

template <class Epi, class Sched>
__device__ __forceinline__ void gemm_phase(LAS unsigned char* lds, const Sched& S, const Epi& E) {
    int tid = threadIdx.x; asm volatile("" : "+v"(tid));
    const int wid = __builtin_amdgcn_readfirstlane(tid >> 6), lane = tid & 63, wr = wid >> 2, wc = wid & 3, fr = lane & 15, fq = lane >> 4;
    unsigned vRC, voffB;
    { int R, C; stage_rc(tid * 16, R, C); const int Rb = (R & ~31) + perm32(R & 31); vRC = (unsigned)(R * PITCH + C * 2); voffB = (unsigned)(Rb * PITCH + C * 2); }
#define PG8_VA(ap) ((ap) ? (((vRC >> 11) << 13) + (vRC & 2047u)) : vRC)
    const size_t kstep = (size_t)(BK * 2);
    const size_t hstep = (size_t)HALF * PITCH;
    const unsigned ldsw = (unsigned)wid * 1024u;
    const int aoff = lds_byte(wr * 64 + fr, fq * 8), boff = lds_byte(wc * 32 + fr, fq * 8);
#define PG8_SA(b, h) (((b) * 2 + (h)) * HTB)
#define PG8_SB(b, h) ((4 + (b) * 2 + (h)) * HTB)
#define PG8_STAGE(bufoff, gbase, voff, d64) do { _Pragma("unroll") for (int _i = 0; _i < 2; ++_i) \
        __builtin_amdgcn_global_load_lds((const unsigned*)((const char*)(gbase) + (size_t)_i * (d64) + (voff)), (LAS unsigned*)(lds + (bufoff) + ldsw + _i * 8192), 16, 0, 0); } while (0)
#define PG8_STAGEB(bufoff, gbase) PG8_STAGE(bufoff, gbase, voffB, (size_t)64 * PITCH)
#define PG8_LDA(dst, b, h) do { _Pragma("unroll") for (int m = 0; m < 4; ++m) _Pragma("unroll") for (int k = 0; k < 2; ++k) dst[m][k] = *(const LAS bf16x8*)(lds + PG8_SA(b, h) + aoff + m * 2048 + k * 1024); } while (0)
#define PG8_LDB(dst, b, h) do { _Pragma("unroll") for (int n = 0; n < 2; ++n) _Pragma("unroll") for (int k = 0; k < 2; ++k) dst[n][k] = *(const LAS bf16x8*)(lds + PG8_SB(b, h) + boff + n * 2048 + k * 1024); } while (0)
#define PG8_MMA(ai, bj, At, Bt) do { __builtin_amdgcn_s_setprio(1); _Pragma("unroll") for (int m = 0; m < 4; ++m) _Pragma("unroll") for (int n = 0; n < 2; ++n) _Pragma("unroll") for (int k = 0; k < 2; ++k) \
        acc[ai][bj][m][n] = __builtin_amdgcn_mfma_f32_16x16x32_bf16(Bt[n][k], At[m][k], acc[ai][bj][m][n], 0, 0, 0); __builtin_amdgcn_s_setprio(0); } while (0)
#define PG8_WAIT_V(n) asm volatile("s_waitcnt vmcnt(" #n ")" ::: "memory")
#define PG8_WAIT_L(n) asm volatile("s_waitcnt lgkmcnt(" #n ")" ::: "memory")
#define PG8_BAR __builtin_amdgcn_s_barrier()
#define PG8_SCHED __builtin_amdgcn_sched_barrier(0)
    Unit cur, nxt; int ui = 0;
    if (!S.next(0, cur)) return;
    f32x4 acc[2][2][4][2];
#pragma unroll
    for (int a = 0; a < 2; ++a)
#pragma unroll
        for (int b = 0; b < 2; ++b)
#pragma unroll
            for (int m = 0; m < 4; ++m)
#pragma unroll
                for (int n = 0; n < 2; ++n) acc[a][b][m][n] = (f32x4){0.f, 0.f, 0.f, 0.f};
    bf16x8 At[4][2], B0[2][2], B1[2][2];
    const char* cA = cur.A; const char* cB = cur.B;
    unsigned voffA = PG8_VA(cur.ap);
    size_t hA = cur.ap ? (size_t)HALF * 8192 : hstep;
    PG8_STAGEB(PG8_SB(0, 0), cB); PG8_STAGEB(PG8_SB(0, 1), cB + hstep); PG8_STAGE(PG8_SA(0, 0), cA, voffA, hA >> 1); PG8_STAGE(PG8_SA(0, 1), cA + hA, voffA, hA >> 1);
    if (wr == 1) PG8_BAR;
    PG8_WAIT_V(2); PG8_BAR;
    PG8_STAGEB(PG8_SB(1, 0), cB + kstep); PG8_STAGE(PG8_SA(1, 0), cA + kstep, voffA, hA >> 1); PG8_STAGEB(PG8_SB(1, 1), cB + hstep + kstep);
    PG8_WAIT_V(6); PG8_BAR;
    for (;;) {
        const bool has_next = S.next(ui + 1, nxt);
        const char* nA = has_next ? nxt.A : cA; const char* nB = has_next ? nxt.B : cB;
        const int nap = has_next ? nxt.ap : cur.ap;
        const unsigned voffN = PG8_VA(nap);
        const size_t hN = nap ? (size_t)HALF * 8192 : hstep;
        const int nt = cur.nt;
        for (int t = 0; t < nt; t += 2) {
            const bool last = (t == nt - 2);
            const char* a1 = cA + (size_t)(t + 1) * kstep;
            const char* a2 = last ? nA : cA + (size_t)(t + 2) * kstep; const char* b2 = last ? nB : cB + (size_t)(t + 2) * kstep;
            const char* a3 = a2 + kstep; const char* b3 = b2 + kstep;
            const unsigned voff2 = last ? voffN : voffA;
            const size_t h2 = last ? hN : hA;
            PG8_LDB(B0, 0, 0); PG8_LDB(B1, 0, 1); PG8_SCHED; PG8_LDA(At, 0, 0); PG8_STAGE(PG8_SA(1, 1), a1 + hA, voffA, hA >> 1);
            PG8_WAIT_V(8); PG8_WAIT_L(0); PG8_BAR; PG8_MMA(0, 0, At, B0); PG8_MMA(0, 1, At, B1); PG8_BAR; PG8_SCHED;
            PG8_LDA(At, 0, 1); PG8_STAGEB(PG8_SB(0, 0), b2); PG8_STAGEB(PG8_SB(0, 1), b2 + hstep); PG8_STAGE(PG8_SA(0, 0), a2, voff2, h2 >> 1);
            PG8_WAIT_V(8); PG8_WAIT_L(0); PG8_BAR; PG8_MMA(1, 0, At, B0); PG8_MMA(1, 1, At, B1); PG8_BAR; PG8_SCHED;
            PG8_LDB(B0, 1, 0); PG8_LDB(B1, 1, 1); PG8_SCHED; PG8_LDA(At, 1, 0); PG8_STAGE(PG8_SA(0, 1), a2 + h2, voff2, h2 >> 1);
            PG8_WAIT_V(8); PG8_WAIT_L(0); PG8_BAR; PG8_MMA(0, 0, At, B0); PG8_MMA(0, 1, At, B1); PG8_BAR; PG8_SCHED;
            PG8_LDA(At, 1, 1); PG8_STAGEB(PG8_SB(1, 0), b3); PG8_STAGEB(PG8_SB(1, 1), b3 + hstep); PG8_STAGE(PG8_SA(1, 0), a3, voff2, h2 >> 1);
            PG8_WAIT_V(8); PG8_WAIT_L(0); PG8_BAR; PG8_MMA(1, 0, At, B0); PG8_MMA(1, 1, At, B1); PG8_BAR; PG8_SCHED;
        }
        if (wr == 0) PG8_BAR;
        E(acc, cur, wr, wc, fr, fq);
        if (!has_next) break;
#pragma unroll
        for (int a = 0; a < 2; ++a)
#pragma unroll
            for (int b = 0; b < 2; ++b)
#pragma unroll
                for (int m = 0; m < 4; ++m)
#pragma unroll
                    for (int n = 0; n < 2; ++n) acc[a][b][m][n] = (f32x4){0.f, 0.f, 0.f, 0.f};
        cur = nxt; cA = nA; cB = nB; ++ui; voffA = voffN; hA = hN;
        if (wr == 1) PG8_BAR;
    }
    PG8_WAIT_V(0);
    PG8_BAR;
#undef PG8_SA
#undef PG8_SB
#undef PG8_STAGE
#undef PG8_STAGEB
#undef PG8_VA
#undef PG8_LDA
#undef PG8_LDB
#undef PG8_MMA
#undef PG8_WAIT_V
#undef PG8_WAIT_L
#undef PG8_BAR
#undef PG8_SCHED
}

struct Epi1 {
    bf16_t* P1; const float* qg; const float* kg;
    __device__ __forceinline__ void operator()(const f32x4 (&acc)[2][2][4][2], const Unit& u, int wr, int wc, int fr, int fq) const {
        const int pn = u.pn;
        const int kind = (pn < 6) ? 0 : (pn < 8) ? 1 : (pn < 10) ? 2 : (pn < 12) ? 3 : (pn < 14) ? 4 : 1;
        const int col0 = pn * BM + wc * 64 + 8 * fq;
        const size_t row0 = (size_t)u.pm * BM + wr * 64 + fr;
        f32x4 gn[2][2];
#pragma unroll
        for (int bj = 0; bj < 2; ++bj)
#pragma unroll
            for (int n = 0; n < 2; ++n) gn[bj][n] = (f32x4){1.f, 1.f, 1.f, 1.f};
        if (kind >= 2) { const float* g = (kind == 2) ? qg : kg; const float sc = (kind == 2) ? QSCALE : 1.0f;
#pragma unroll
            for (int bj = 0; bj < 2; ++bj)
#pragma unroll
                for (int n = 0; n < 2; ++n) gn[bj][n] = *(const f32x4*)(g + 32 * bj + 8 * fq + 4 * n) * sc; }
        if (kind == 4) {
            const int hh = 4 * (pn - 12) + wc; const int tok0 = u.pm * BM + wr * 64 + fr; const int bb = tok0 >> 11;
            bf16_t* vb = P1 + (size_t)bb * SEQ * N1 + 3072 + 64 * hh;
#pragma unroll
            for (int ai = 0; ai < 2; ++ai)
#pragma unroll
                for (int m = 0; m < 4; ++m) { const int sq = (tok0 + ai * HALF + m * 16) & (SEQ - 1); const int cs = (sq & 48) | ((sq & 4) << 1) | ((sq & 8) >> 1) | (sq & 3);
                    unsigned off = (unsigned)((sq >> 6) * N1 + cs + (8 * fq) * 32 * N1); asm volatile("" : "+v"(off));
#pragma unroll
                    for (int bj = 0; bj < 2; ++bj)
#pragma unroll
                        for (int n = 0; n < 2; ++n) { const f32x4 x = acc[ai][bj][m][n]; const unsigned w0 = cvt_pk_bf16(x[0], x[1]), w1 = cvt_pk_bf16(x[2], x[3]); bf16_t* bp = vb + off + (unsigned)((32 * bj + 4 * n) * 32 * N1);
                            bp[0 * 32 * N1] = (bf16_t)(w0 & 0xffffu); bp[1 * 32 * N1] = (bf16_t)(w0 >> 16); bp[2 * 32 * N1] = (bf16_t)(w1 & 0xffffu); bp[3 * 32 * N1] = (bf16_t)(w1 >> 16); }
                    asm volatile("" ::: "memory"); }
            return;
        }
#pragma unroll
        for (int ai = 0; ai < 2; ++ai)
#pragma unroll
            for (int m = 0; m < 4; ++m) {
                bf16_t* rowp = P1 + (row0 + ai * HALF + m * 16) * N1 + col0;
                float rs = 1.f;
                if (kind >= 2) { float ss = 0.f;
#pragma unroll
                    for (int bj = 0; bj < 2; ++bj)
#pragma unroll
                        for (int n = 0; n < 2; ++n) { const f32x4 x = acc[ai][bj][m][n]; ss += (x[0] * x[0] + x[1] * x[1]) + (x[2] * x[2] + x[3] * x[3]); }
                    ss += __shfl_xor(ss, 16); ss += __shfl_xor(ss, 32);
                    rs = __builtin_amdgcn_rsqf(ss * (1.0f / 64.0f) + EPS); }
#pragma unroll
                for (int bj = 0; bj < 2; ++bj) { f32x4 v0 = acc[ai][bj][m][0], v1 = acc[ai][bj][m][1];
                    if (kind == 1) {
#pragma unroll
                        for (int j = 0; j < 4; ++j) { v0[j] = v0[j] * sigmoidf_(v0[j]); v1[j] = v1[j] * sigmoidf_(v1[j]); } }
                    else if (kind >= 2) { v0 = v0 * rs * gn[bj][0]; v1 = v1 * rs * gn[bj][1]; }
                    u32x4 w; w.x = cvt_pk_bf16(v0[0], v0[1]); w.y = cvt_pk_bf16(v0[2], v0[3]); w.z = cvt_pk_bf16(v1[0], v1[1]); w.w = cvt_pk_bf16(v1[2], v1[3]);
                    *(u32x4*)(rowp + 32 * bj) = w; }
                asm volatile("" ::: "memory");
            }
    }
};
struct Epi5 {
    const float* bgate; bf16_t* gsc; bf16_t* gy; bf16_t* MG;
    __device__ __forceinline__ void operator()(const f32x4 (&acc)[2][2][4][2], const Unit& u, int wr, int wc, int fr, int fq) const {
        const int sub = u.sub;
        const int lc0 = wc * 32 + 8 * fq, lr0 = wr * 64 + fr;
        int toff = lr0 * 256 + lc0; asm volatile("" : "+v"(toff));
        if (sub == 0 || sub == 2) {
            const float* bp = bgate + (sub == 2 ? 1024 : 0) + u.pn * BM + lc0;
            f32x4 bb[2][2];
#pragma unroll
            for (int bj = 0; bj < 2; ++bj) { bb[bj][0] = *(const f32x4*)(bp + bj * HALF); bb[bj][1] = *(const f32x4*)(bp + bj * HALF + 4); }
#pragma unroll
            for (int ai = 0; ai < 2; ++ai)
#pragma unroll
                for (int m = 0; m < 4; ++m) {
#pragma unroll
                    for (int bj = 0; bj < 2; ++bj) { const f32x4 a0 = acc[ai][bj][m][0] + bb[bj][0], a1 = acc[ai][bj][m][1] + bb[bj][1];
                        u32x4 w; w.x = cvt_pk_bf16(sigmoidf_(a0[0]), sigmoidf_(a0[1])); w.y = cvt_pk_bf16(sigmoidf_(a0[2]), sigmoidf_(a0[3]));
                        w.z = cvt_pk_bf16(sigmoidf_(a1[0]), sigmoidf_(a1[1])); w.w = cvt_pk_bf16(sigmoidf_(a1[2]), sigmoidf_(a1[3]));
                        *(u32x4*)(gsc + toff + (ai * HALF + m * 16) * 256 + bj * HALF) = w; }
                    asm volatile("" ::: "memory"); }
        } else if (sub == 1) {
#pragma unroll
            for (int ai = 0; ai < 2; ++ai)
#pragma unroll
                for (int m = 0; m < 4; ++m) {
#pragma unroll
                    for (int bj = 0; bj < 2; ++bj) { const int o = toff + (ai * HALF + m * 16) * 256 + bj * HALF; const f32x4 a0 = acc[ai][bj][m][0], a1 = acc[ai][bj][m][1];
                        const u32x4 g = *(const u32x4*)(gsc + o); u32x4 w;
                        w.x = cvt_pk_bf16(bflo(g.x) * a0[0], bfhi(g.x) * a0[1]); w.y = cvt_pk_bf16(bflo(g.y) * a0[2], bfhi(g.y) * a0[3]);
                        w.z = cvt_pk_bf16(bflo(g.z) * a1[0], bfhi(g.z) * a1[1]); w.w = cvt_pk_bf16(bflo(g.w) * a1[2], bfhi(g.w) * a1[3]);
                        *(u32x4*)(gy + o) = w; }
                    asm volatile("" ::: "memory"); }
        } else {
            bf16_t* mg = MG + ((size_t)u.pm * BM + lr0) * DM + u.pn * BM + lc0;
#pragma unroll
            for (int ai = 0; ai < 2; ++ai)
#pragma unroll
                for (int m = 0; m < 4; ++m) {
#pragma unroll
                    for (int bj = 0; bj < 2; ++bj) { const int o = toff + (ai * HALF + m * 16) * 256 + bj * HALF; const f32x4 a0 = acc[ai][bj][m][0], a1 = acc[ai][bj][m][1];
                        const u32x4 g = *(const u32x4*)(gsc + o); const u32x4 y = *(const u32x4*)(gy + o); u32x4 w;
                        w.x = cvt_pk_bf16(bflo(y.x) + bflo(g.x) * a0[0], bfhi(y.x) + bfhi(g.x) * a0[1]); w.y = cvt_pk_bf16(bflo(y.y) + bflo(g.y) * a0[2], bfhi(y.y) + bfhi(g.y) * a0[3]);
                        w.z = cvt_pk_bf16(bflo(y.z) + bflo(g.z) * a1[0], bfhi(y.z) + bfhi(g.z) * a1[1]); w.w = cvt_pk_bf16(bflo(y.w) + bflo(g.w) * a1[2], bfhi(y.w) + bfhi(g.w) * a1[3]);
                        *(u32x4*)(mg + (ai * HALF + m * 16) * DM + bj * HALF) = w; }
                    asm volatile("" ::: "memory"); }
        }
    }
};
struct Epi6 {
    const float* x; float* out;
    __device__ __forceinline__ void operator()(const f32x4 (&acc)[2][2][4][2], const Unit& u, int wr, int wc, int fr, int fq) const {
        const int lc0 = u.pn * BM + wc * 32 + 8 * fq; const size_t row0 = (size_t)u.pm * BM + wr * 64 + fr;
#pragma unroll
        for (int ai = 0; ai < 2; ++ai)
#pragma unroll
            for (int m = 0; m < 4; ++m) { const size_t off = (row0 + ai * HALF + m * 16) * DM + lc0;
#pragma unroll
                for (int bj = 0; bj < 2; ++bj) { const f32x4 x0 = __builtin_nontemporal_load((const f32x4*)(x + off + bj * HALF)), x1 = __builtin_nontemporal_load((const f32x4*)(x + off + bj * HALF + 4));
                    __builtin_nontemporal_store(x0 + acc[ai][bj][m][0], (f32x4*)(out + off + bj * HALF)); __builtin_nontemporal_store(x1 + acc[ai][bj][m][1], (f32x4*)(out + off + bj * HALF + 4)); }
                asm volatile("" ::: "memory"); }
    }
};
}

#define XB_TMO      128
#define XB_XCNT(j)  (256  + 64 * (j))
#define XB_XSUB(j)  (1280 + 64 * (j))
#define XB_XGEN(j)  (2304 + 64 * (j))
#define XB_TOP      3328
#define XB_TOPGEN   3392
#define XCD_BAR_WORDS 3456
#define XB_SPIN_CAP (1u << 18)

__device__ __forceinline__ unsigned xb_ld(unsigned* p)              { return __hip_atomic_load(p, __ATOMIC_RELAXED, __HIP_MEMORY_SCOPE_AGENT); }
__device__ __forceinline__ unsigned xb_add(unsigned* p, unsigned v) { return __hip_atomic_fetch_add(p, v, __ATOMIC_RELAXED, __HIP_MEMORY_SCOPE_AGENT); }
__device__ __forceinline__ unsigned xb_xcc_id() { return (unsigned)__builtin_amdgcn_s_getreg((3 << 11) | 20) & 0xFu; }
#define XB_SPIN(cond, bar) do { unsigned _sp = 0; while (cond) { __builtin_amdgcn_s_sleep(1); \
    if ((++_sp & 255u) == 0u) { if (xb_ld(&(bar)[XB_TMO])) break; if (_sp > XB_SPIN_CAP) { atomicAdd(&(bar)[XB_TMO], 1u); break; } } } } while (0)

struct XcdBarrier {
    unsigned* bar; unsigned x;
    volatile LAS unsigned* st;
};

__device__ __forceinline__ XcdBarrier xcd_barrier_post(unsigned* bar, volatile LAS unsigned* st) {
    XcdBarrier b; b.bar = bar; b.x = xb_xcc_id(); b.st = st;
    if (threadIdx.x == 0) (void)xb_add(&bar[XB_XCNT(b.x)], 1u);
    return b;
}
__device__ __forceinline__ void xcd_barrier_complete(unsigned* bar, unsigned x, unsigned& nloc, unsigned& nx) {
    const unsigned G = gridDim.x * gridDim.y * gridDim.z;
    unsigned sum, cnt, mine, sp = 0u;
    for (;;) {
        sum = 0u; cnt = 0u; mine = 0u;
#pragma unroll
        for (unsigned j = 0; j < 16; ++j) { const unsigned c = xb_ld(&bar[XB_XCNT(j)]); sum += c; cnt += (c > 0u) ? 1u : 0u; mine = (j == x) ? c : mine; }
        if (sum == G) break;
        __builtin_amdgcn_s_sleep(1);
        if ((++sp & 255u) == 0u) { if (xb_ld(&bar[XB_TMO])) break; if (sp > XB_SPIN_CAP) { atomicAdd(&bar[XB_TMO], 1u); break; } }
    }
    nloc = mine > 0u ? mine : 1u; nx = cnt > 0u ? cnt : 1u;
}

__device__ __forceinline__ void xcd_barrier(const XcdBarrier& b) {
    asm volatile("s_waitcnt vmcnt(0)" ::: "memory");
    __syncthreads();
    if (threadIdx.x == 0) {
        unsigned* bar = b.bar;
        __builtin_amdgcn_s_waitcnt(0);
        unsigned nloc = b.st[0], nx = b.st[1];
        if (nloc == 0u) { xcd_barrier_complete(bar, b.x, nloc, nx); b.st[0] = nloc; b.st[1] = nx; }
        const unsigned old = xb_add(&bar[XB_XSUB(b.x)], 1u);
        const unsigned gen = old / nloc;
        if (old + 1u == (gen + 1u) * nloc) {
            __builtin_amdgcn_fence(__ATOMIC_RELEASE, "agent");
            asm volatile("s_waitcnt vmcnt(0)" ::: "memory");
            const unsigned og = xb_add(&bar[XB_TOP], 1u);
            const unsigned tg = og / nx;
            if (og + 1u == (tg + 1u) * nx) xb_add(&bar[XB_TOPGEN], 1u);
            else XB_SPIN(xb_ld(&bar[XB_TOPGEN]) == tg, bar);
            __builtin_amdgcn_fence(__ATOMIC_ACQUIRE, "agent");
            xb_add(&bar[XB_XGEN(b.x)], 1u);
            asm volatile("s_waitcnt vmcnt(0)" ::: "memory");
        } else {
            XB_SPIN(xb_ld(&bar[XB_XGEN(b.x)]) == gen, bar);
            __builtin_amdgcn_fence(__ATOMIC_ACQUIRE, "agent");
            asm volatile("s_waitcnt vmcnt(0)" ::: "memory");
        }
    }
    __syncthreads();
}

struct Args {
    const float *x, *norm_gain, *w_in, *b_gate, *conv_w, *a_log, *dt_bias, *dn_out_gain, *sb_q_gain, *sb_k_gain, *w_up_a, *w_up_b, *w_out;
    float* out; unsigned char* ws; int never; int pad;
};

__device__ __forceinline__ void p0_transpose_item(const float* W, int ldw, int src_col0, int k0, bf16_t* WT, int dst_row0, int dst_k0, LAS float* scr, int lane) {
#pragma unroll 8
    for (int i = 0; i < 32; ++i) { const int kk = 2 * i + (lane >> 5); scr[kk * 33 + (lane & 31)] = W[(size_t)(k0 + kk) * ldw + src_col0 + (lane & 31)]; }
    asm volatile("s_waitcnt lgkmcnt(0)" ::: "memory");
    const int c = lane & 7;
#pragma unroll
    for (int j = 0; j < 4; ++j) { const int n = (lane >> 3) + 8 * j; const LAS float* s = scr + (8 * c) * 33 + n;
        u32x4 o; o.x = cvt_pk_bf16(s[0 * 33], s[1 * 33]); o.y = cvt_pk_bf16(s[2 * 33], s[3 * 33]); o.z = cvt_pk_bf16(s[4 * 33], s[5 * 33]); o.w = cvt_pk_bf16(s[6 * 33], s[7 * 33]);
        *(u32x4*)(WT + (size_t)(dst_row0 + n) * 1024 + dst_k0 + 8 * c) = o; }
    asm volatile("s_waitcnt lgkmcnt(0)" ::: "memory");
}


#define MFMA16(a, b, c) __builtin_amdgcn_mfma_f32_16x16x32_bf16((a), (b), (c), 0, 0, 0)
__device__ __forceinline__ bf16x8 pack8(const f32x4 lo, const f32x4 hi) {
    u32x4 w;
    asm volatile("s_nop 7\n\ts_nop 7\n\ts_nop 3\n\tv_cvt_pk_bf16_f32 %0, %4, %5\n\tv_cvt_pk_bf16_f32 %1, %6, %7\n\tv_cvt_pk_bf16_f32 %2, %8, %9\n\tv_cvt_pk_bf16_f32 %3, %10, %11\n\ts_nop 1"
                 : "=&v"(w.x), "=&v"(w.y), "=&v"(w.z), "=&v"(w.w) : "v"(lo[0]), "v"(lo[1]), "v"(lo[2]), "v"(lo[3]), "v"(hi[0]), "v"(hi[1]), "v"(hi[2]), "v"(hi[3]));
    return __builtin_bit_cast(bf16x8, w);
}
#define LDS_FENCE() asm volatile("s_waitcnt lgkmcnt(0)" ::: "memory")

__device__ __forceinline__ void dn_rows_load(const bf16_t* QKVA, size_t row0, int col0, int lane, u32x4 (&r)[8]) {
    const bf16_t* rp = QKVA + (row0 + lane) * 1536 + col0;
#pragma unroll
    for (int grp = 0; grp < 8; ++grp) r[grp] = *(const u32x4*)(rp + 8 * grp);
}
__device__ __forceinline__ void dn_rows_to_lds(const u32x4 (&r)[8], LAS bf16_t* XT, int lane) {
#pragma unroll
    for (int grp = 0; grp < 8; ++grp) { const u32x4 w = r[grp]; LAS bf16_t* d = XT + (8 * grp) * 72 + lane;
        d[0 * 72] = (bf16_t)(w.x & 0xffffu); d[1 * 72] = (bf16_t)(w.x >> 16); d[2 * 72] = (bf16_t)(w.y & 0xffffu); d[3 * 72] = (bf16_t)(w.y >> 16);
        d[4 * 72] = (bf16_t)(w.z & 0xffffu); d[5 * 72] = (bf16_t)(w.z >> 16); d[6 * 72] = (bf16_t)(w.w & 0xffffu); d[7 * 72] = (bf16_t)(w.w >> 16); }
}

__device__ __forceinline__ void dn_prep(int task, LAS unsigned char* L, const bf16_t* QKVA, const float* BG, unsigned char* REC, bf16_t* UF, float* GE, int lane) {
    const int n = task & 31, h = (task >> 5) & 3, b = task >> 7;
    const size_t row0 = (size_t)b * SEQ + n * 64;
    LAS bf16_t* Mm = (LAS bf16_t*)L; LAS bf16_t* TT = (LAS bf16_t*)L;
    LAS bf16_t* XT = (LAS bf16_t*)(L + 8192);
    LAS float* GC = (LAS float*)(L + 17408); LAS float* BT = GC + 64; LAS float* DSC = GC + 128; LAS float* EGC = GC + 192;
    const int fr = lane & 15, fq = lane >> 4;
    unsigned char* rec = REC + (size_t)task * REC_BYTES;
    const float g = __hip_atomic_load(BG + (row0 + lane) * 8 + 4 + h, __ATOMIC_RELAXED, __HIP_MEMORY_SCOPE_AGENT), beta = __hip_atomic_load(BG + (row0 + lane) * 8 + h, __ATOMIC_RELAXED, __HIP_MEMORY_SCOPE_AGENT);
    float gc = g;
#pragma unroll
    for (int o = 1; o < 64; o <<= 1) { const float v = __shfl_up(gc, o); if (lane >= o) gc += v; }
    const float gl = __shfl(gc, 63);
    const float egc = __expf(gc);
    GC[lane] = gc; BT[lane] = beta; DSC[lane] = __expf(gl - gc); EGC[lane] = egc;
    if (lane == 0) GE[task] = __expf(gl);
    LDS_FENCE();
    bf16x8 kf[4][4];
#pragma unroll
    for (int mt = 0; mt < 4; ++mt)
#pragma unroll
        for (int ks = 0; ks < 4; ++ks) { const bf16_t* rp = QKVA + (row0 + 16 * mt + fr) * 1536 + 128 * h + 32 * ks + 4 * fq + 512;
            const u32x2 kl = *(const u32x2*)(rp), kh = *(const u32x2*)(rp + 16);
            u32x4 kw; kw.x = kl.x; kw.y = kl.y; kw.z = kh.x; kw.w = kh.y; kf[mt][ks] = __builtin_bit_cast(bf16x8, kw); }
    u32x4 qnx[4];
#pragma unroll
    for (int ks = 0; ks < 4; ++ks) { const bf16_t* rp = QKVA + (row0 + fr) * 1536 + 128 * h + 32 * ks + 4 * fq; const u32x2 ql = *(const u32x2*)(rp), qh = *(const u32x2*)(rp + 16); qnx[ks].x = ql.x; qnx[ks].y = ql.y; qnx[ks].z = qh.x; qnx[ks].w = qh.y; }
#pragma unroll
    for (int nt = 0; nt < 4; ++nt) { const float gci = GC[16 * nt + fr], sc = EGC[16 * nt + fr]; const int ic = 16 * nt + fr;
        bf16x8 qf[4]; u32x4 qw[4];
#pragma unroll
        for (int ks = 0; ks < 4; ++ks) qw[ks] = qnx[ks];
        if (nt < 3) {
#pragma unroll
            for (int ks = 0; ks < 4; ++ks) { const bf16_t* rp = QKVA + (row0 + 16 * (nt + 1) + fr) * 1536 + 128 * h + 32 * ks + 4 * fq; const u32x2 ql = *(const u32x2*)(rp), qh = *(const u32x2*)(rp + 16); qnx[ks].x = ql.x; qnx[ks].y = ql.y; qnx[ks].z = qh.x; qnx[ks].w = qh.y; } }
#pragma unroll
        for (int ks = 0; ks < 4; ++ks) { const u32x4 w = qw[ks]; qf[ks] = __builtin_bit_cast(bf16x8, w); u32x4 o;
            o.x = cvt_pk_safe(bflo(w.x) * sc, bfhi(w.x) * sc); o.y = cvt_pk_safe(bflo(w.y) * sc, bfhi(w.y) * sc); o.z = cvt_pk_safe(bflo(w.z) * sc, bfhi(w.z) * sc); o.w = cvt_pk_safe(bflo(w.w) * sc, bfhi(w.w) * sc);
            __builtin_nontemporal_store((u32x4)(o), (u32x4*)(rec + 16384 + ((ks * 4 + nt) * 64 + lane) * 16)); }
#pragma unroll
        for (int ks2 = 0; ks2 < 2; ++ks2) { f32x4 d0 = {0.f, 0.f, 0.f, 0.f}, d1 = {0.f, 0.f, 0.f, 0.f};
#pragma unroll
            for (int ks = 0; ks < 4; ++ks) { d0 = MFMA16(kf[2 * ks2][ks], qf[ks], d0); d1 = MFMA16(kf[2 * ks2 + 1][ks], qf[ks], d1); }
            const f32x4 gj0 = *(const LAS f32x4*)(GC + 32 * ks2 + 4 * fq), gj1 = *(const LAS f32x4*)(GC + 32 * ks2 + 16 + 4 * fq);
#pragma unroll
            for (int r = 0; r < 4; ++r) { const int j0 = 32 * ks2 + 4 * fq + r;
                d0[r] = (j0 <= ic) ? d0[r] * __expf(gci - gj0[r]) : 0.f; d1[r] = (j0 + 16 <= ic) ? d1[r] * __expf(gci - gj1[r]) : 0.f; }
            __builtin_nontemporal_store((bf16x8)(pack8(d0, d1)), (bf16x8*)(rec + 49152 + ((ks2 * 4 + nt) * 64 + lane) * 16)); }
        __builtin_amdgcn_sched_barrier(0); }
#pragma unroll
    for (int mt = 0; mt < 4; ++mt)
#pragma unroll
        for (int nt = 0; nt <= mt; ++nt) { f32x4 d = {0.f, 0.f, 0.f, 0.f};
#pragma unroll
            for (int ks = 0; ks < 4; ++ks) d = MFMA16(kf[mt][ks], kf[nt][ks], d);
            const float gcj = GC[16 * nt + fr]; const f32x4 gi = *(const LAS f32x4*)(GC + 16 * mt + 4 * fq), bi = *(const LAS f32x4*)(BT + 16 * mt + 4 * fq);
#pragma unroll
            for (int r = 0; r < 4; r += 2) { const int i = 16 * mt + 4 * fq + r, j = 16 * nt + fr; const float v0 = (j < i) ? bi[r] * d[r] * __expf(gi[r] - gcj) : 0.f, v1 = (j < i + 1) ? bi[r + 1] * d[r + 1] * __expf(gi[r + 1] - gcj) : 0.f;
                const unsigned w = cvt_pk_safe(v0, v1); Mm[i * 64 + j] = (bf16_t)(w & 0xffffu); Mm[(i + 1) * 64 + j] = (bf16_t)(w >> 16); } }
    __builtin_amdgcn_sched_barrier(0);
    u32x4 xr[8];
    dn_rows_load(QKVA, row0, 512 + 128 * h, lane, xr);
    LDS_FENCE();
    float t[64];
#define INV_ROWS(I0) _Pragma("unroll") for (int i = (I0); i < (I0) + 16; ++i) { float acc = (lane == i) ? 1.f : 0.f; \
        _Pragma("unroll") for (int jj = 0; jj < (i + 7) / 8; ++jj) { const u32x4 mv = *(const LAS u32x4*)(Mm + i * 64 + 8 * jj); \
            if (8 * jj + 0 < i) acc -= bflo(mv.x) * t[8 * jj + 0]; if (8 * jj + 1 < i) acc -= bfhi(mv.x) * t[8 * jj + 1]; if (8 * jj + 2 < i) acc -= bflo(mv.y) * t[8 * jj + 2]; if (8 * jj + 3 < i) acc -= bfhi(mv.y) * t[8 * jj + 3]; \
            if (8 * jj + 4 < i) acc -= bflo(mv.z) * t[8 * jj + 4]; if (8 * jj + 5 < i) acc -= bfhi(mv.z) * t[8 * jj + 5]; if (8 * jj + 6 < i) acc -= bflo(mv.w) * t[8 * jj + 6]; if (8 * jj + 7 < i) acc -= bfhi(mv.w) * t[8 * jj + 7]; } \
        t[i] = acc; }
    INV_ROWS(0) INV_ROWS(16) INV_ROWS(32) INV_ROWS(48)
#undef INV_ROWS
    LDS_FENCE();
    { const float s1 = beta * egc;
#pragma unroll
      for (int i = 0; i < 64; i += 2) { const unsigned w1 = cvt_pk_bf16(t[i] * s1, t[i + 1] * s1); TT[i * 64 + lane] = (bf16_t)(w1 & 0xffffu); TT[(i + 1) * 64 + lane] = (bf16_t)(w1 >> 16); } }
#pragma unroll
    for (int hf = 0; hf < 2; ++hf) {
        LDS_FENCE();
        dn_rows_to_lds(xr, XT, lane);
        if (hf == 0) dn_rows_load(QKVA, row0, 512 + 128 * h + 64, lane, xr); else dn_rows_load(QKVA, row0, 1024 + 128 * h, lane, xr);
        LDS_FENCE();
#pragma unroll
        for (int ks2 = 0; ks2 < 2; ++ks2) { const f32x4 s0 = *(const LAS f32x4*)(DSC + 32 * ks2 + 4 * fq), s1 = *(const LAS f32x4*)(DSC + 32 * ks2 + 16 + 4 * fq);
#pragma unroll
            for (int m4 = 0; m4 < 4; ++m4) { const LAS bf16_t* p = XT + (16 * m4 + fr) * 72 + 32 * ks2 + 4 * fq;
                const u32x2 lo = *(const LAS u32x2*)p, hi = *(const LAS u32x2*)(p + 16); u32x4 o;
                o.x = cvt_pk_bf16(bflo(lo.x) * s0[0], bfhi(lo.x) * s0[1]); o.y = cvt_pk_bf16(bflo(lo.y) * s0[2], bfhi(lo.y) * s0[3]);
                o.z = cvt_pk_bf16(bflo(hi.x) * s1[0], bfhi(hi.x) * s1[1]); o.w = cvt_pk_bf16(bflo(hi.y) * s1[2], bfhi(hi.y) * s1[3]);
                __builtin_nontemporal_store((u32x4)(o), (u32x4*)(rec + 32768 + ((ks2 * 8 + 4 * hf + m4) * 64 + lane) * 16)); } }
#pragma unroll
        for (int nt = 0; nt < 4; ++nt) { bf16x8 tb[2];
#pragma unroll
            for (int ks2 = 0; ks2 < 2; ++ks2) tb[ks2] = *(const LAS bf16x8*)(TT + (16 * nt + fr) * 64 + 32 * ks2 + 8 * fq);
            f32x4 d[4];
#pragma unroll
            for (int m4 = 0; m4 < 4; ++m4) { d[m4] = (f32x4){0.f, 0.f, 0.f, 0.f};
#pragma unroll
                for (int ks2 = 0; ks2 < 2; ++ks2) d[m4] = MFMA16(*(const LAS bf16x8*)(XT + (16 * m4 + fr) * 72 + 32 * ks2 + 8 * fq), tb[ks2], d[m4]); }
#pragma unroll
            for (int kl = 0; kl < 2; ++kl) __builtin_nontemporal_store((bf16x8)(pack8(-d[2 * kl], -d[2 * kl + 1])), (bf16x8*)(rec + (((2 * hf + kl) * 4 + nt) * 64 + lane) * 16)); }
    }
    LDS_FENCE();
    {
#pragma unroll
      for (int i = 0; i < 64; i += 2) { const unsigned w2 = cvt_pk_bf16(t[i] * beta, t[i + 1] * beta); TT[i * 64 + lane] = (bf16_t)(w2 & 0xffffu); TT[(i + 1) * 64 + lane] = (bf16_t)(w2 >> 16); } }
    bf16_t* uf = UF + (size_t)task * 8192;
#pragma unroll
    for (int hf = 0; hf < 2; ++hf) {
        LDS_FENCE();
        dn_rows_to_lds(xr, XT, lane);
        if (hf == 0) dn_rows_load(QKVA, row0, 1024 + 128 * h + 64, lane, xr);
        LDS_FENCE();
#pragma unroll
        for (int mt = 0; mt < 4; ++mt) { bf16x8 ta[2];
#pragma unroll
            for (int ks2 = 0; ks2 < 2; ++ks2) ta[ks2] = *(const LAS bf16x8*)(TT + (16 * mt + fr) * 64 + 32 * ks2 + 8 * fq);
#pragma unroll
            for (int n4 = 0; n4 < 4; ++n4) { f32x4 d = {0.f, 0.f, 0.f, 0.f};
#pragma unroll
                for (int ks2 = 0; ks2 < 2; ++ks2) d = MFMA16(ta[ks2], *(const LAS bf16x8*)(XT + (16 * n4 + fr) * 72 + 32 * ks2 + 8 * fq), d);
                u32x2 o; o.x = cvt_pk_safe(d[0], d[1]); o.y = cvt_pk_safe(d[2], d[3]); __builtin_nontemporal_store(o, (u32x2*)(uf + (((4 * hf + n4) * 4 + mt) * 64 + lane) * 4)); } }
    }
    LDS_FENCE();
}

#define SCAN_BAR() do { asm volatile("s_waitcnt lgkmcnt(0)" ::: "memory"); __builtin_amdgcn_s_barrier(); asm volatile("" ::: "memory"); } while (0)
__device__ __forceinline__ void dn_scan_wg(int unit, LAS unsigned char* lds, const unsigned char* REC, const bf16_t* UF, const float* GE, bf16_t* ORAW, int tid, int wave, int lane) {
    const int bh = unit, b = bh >> 2, h = bh & 3;
    const int fr = lane & 15, fq = lane >> 4;
    constexpr int IMG = REC_BYTES + 16384;
    if (wave >= 4) {
        const int lt = tid - 256; const unsigned char* rbase = REC + (size_t)(bh * 32) * REC_BYTES + lt * 16; const unsigned char* ubase = (const unsigned char*)UF + (size_t)(bh * 32) * 16384 + lt * 16;
        u32x4 A[18], B[18];
#define LREC(dst, r) do { const unsigned char* _p = rbase + (size_t)(r) * REC_BYTES; const unsigned char* _u = ubase + (size_t)(r) * 16384; \
            _Pragma("unroll") for (int _c = 0; _c < 14; ++_c) dst[_c] = __builtin_nontemporal_load((const u32x4*)(_p + _c * 4096)); _Pragma("unroll") for (int _c = 0; _c < 4; ++_c) dst[14 + _c] = __builtin_nontemporal_load((const u32x4*)(_u + _c * 4096)); } while (0)
#define SREC(src, buf) do { _Pragma("unroll") for (int _c = 0; _c < 18; ++_c) *(LAS u32x4*)(lds + (buf) * IMG + _c * 4096 + lt * 16) = src[_c]; } while (0)
        LREC(B, 0); LREC(A, 1);
        SREC(B, 0);
        SCAN_BAR();
        for (int n = 0; n < 32; n += 2) {
            if (n + 2 < 32) LREC(B, n + 2);
            SREC(A, (n + 1) & 1);
            SCAN_BAR();
            if (n + 3 < 32) LREC(A, n + 3);
            if (n + 2 < 32) SREC(B, (n + 2) & 1);
            SCAN_BAR();
        }
#undef LREC
#undef SREC
        return;
    }
    const int sl0 = 2 * wave;
    f32x4 S[2][8]; bf16x8 Sb[2][4];
#pragma unroll
    for (int cg = 0; cg < 2; ++cg) {
#pragma unroll
        for (int i = 0; i < 8; ++i) S[cg][i] = (f32x4){0.f, 0.f, 0.f, 0.f};
#pragma unroll
        for (int i = 0; i < 4; ++i) Sb[cg][i] = (bf16x8){0, 0, 0, 0, 0, 0, 0, 0}; }
    const float gev = GE[bh * 32 + (lane & 31)];
    float ge_all = gev; asm volatile("s_waitcnt vmcnt(0)" : "+v"(ge_all) :: "memory");
    SCAN_BAR();
    for (int n = 0; n < 32; ++n) {
        const LAS unsigned char* img = lds + (n & 1) * IMG;
        const LAS unsigned char* rec = img + lane * 16;
        const float ge = __shfl(ge_all, n);
        f32x4 vn[2][4];
#pragma unroll
        for (int cg = 0; cg < 2; ++cg)
#pragma unroll
            for (int mt = 0; mt < 4; ++mt) { const u32x2 uu = *(const LAS u32x2*)(img + REC_BYTES + (((sl0 + cg) * 4 + mt) * 64 + lane) * 8); vn[cg][mt] = (f32x4){bflo(uu.x), bfhi(uu.x), bflo(uu.y), bfhi(uu.y)}; }
        bf16x8 fa[4], fb[4];
#define LDF(dst, off) do { _Pragma("unroll") for (int _i = 0; _i < 4; ++_i) dst[_i] = *(const LAS bf16x8*)(rec + (off) + _i * 1024); } while (0)
#define MM4(accv, fr_, bsel) do { _Pragma("unroll") for (int _i = 0; _i < 4; ++_i) { accv[0][_i] = MFMA16(fr_[_i], bsel(0), accv[0][_i]); accv[1][_i] = MFMA16(fr_[_i], bsel(1), accv[1][_i]); } } while (0)
#define SBK0(cg) Sb[cg][0]
#define SBK1(cg) Sb[cg][1]
#define SBK2(cg) Sb[cg][2]
#define SBK3(cg) Sb[cg][3]
#define VBK0(cg) Vb[cg][0]
#define VBK1(cg) Vb[cg][1]
        LDF(fa, 0); LDF(fb, 4096);
        MM4(vn, fa, SBK0); LDF(fa, 8192);
        MM4(vn, fb, SBK1); LDF(fb, 12288);
        MM4(vn, fa, SBK2); LDF(fa, 16384);
        MM4(vn, fb, SBK3); LDF(fb, 16384 + 4096);
        bf16x8 Vb[2][2];
#pragma unroll
        for (int cg = 0; cg < 2; ++cg) { Vb[cg][0] = pack8(vn[cg][0], vn[cg][1]); Vb[cg][1] = pack8(vn[cg][2], vn[cg][3]); }
        f32x4 o[2][4];
#pragma unroll
        for (int cg = 0; cg < 2; ++cg)
#pragma unroll
            for (int mt = 0; mt < 4; ++mt) o[cg][mt] = (f32x4){0.f, 0.f, 0.f, 0.f};
        MM4(o, fa, SBK0);  LDF(fa, 16384 + 8192);
        MM4(o, fb, SBK1);  LDF(fb, 16384 + 12288);
        MM4(o, fa, SBK2);  LDF(fa, 49152);
        MM4(o, fb, SBK3);  LDF(fb, 49152 + 4096);
        MM4(o, fa, VBK0);  LDF(fa, 32768);
        MM4(o, fb, VBK1);  LDF(fb, 32768 + 4096);
#pragma unroll
        for (int i = 0; i < 4; ++i) { S[0][i] = MFMA16(fa[i], Vb[0][0], S[0][i] * ge); S[1][i] = MFMA16(fa[i], Vb[1][0], S[1][i] * ge); }
        LDF(fa, 32768 + 8192);
#pragma unroll
        for (int i = 0; i < 4; ++i) { S[0][4 + i] = MFMA16(fb[i], Vb[0][0], S[0][4 + i] * ge); S[1][4 + i] = MFMA16(fb[i], Vb[1][0], S[1][4 + i] * ge); }
        LDF(fb, 32768 + 12288);
#pragma unroll
        for (int cg = 0; cg < 2; ++cg) { bf16_t* op = ORAW + ((size_t)b * SEQ + 64 * n + 4 * fq) * 512 + 128 * h + 16 * (sl0 + cg) + fr;
#pragma unroll
            for (int mt = 0; mt < 4; ++mt) { const unsigned w0 = cvt_pk_safe(o[cg][mt][0], o[cg][mt][1]), w1 = cvt_pk_safe(o[cg][mt][2], o[cg][mt][3]);
                op[(16 * mt + 0) * 512] = (bf16_t)(w0 & 0xffffu); op[(16 * mt + 1) * 512] = (bf16_t)(w0 >> 16); op[(16 * mt + 2) * 512] = (bf16_t)(w1 & 0xffffu); op[(16 * mt + 3) * 512] = (bf16_t)(w1 >> 16); } }
#pragma unroll
        for (int i = 0; i < 4; ++i) { S[0][i] = MFMA16(fa[i], Vb[0][1], S[0][i]); S[1][i] = MFMA16(fa[i], Vb[1][1], S[1][i]); }
#pragma unroll
        for (int i = 0; i < 4; ++i) { S[0][4 + i] = MFMA16(fb[i], Vb[0][1], S[0][4 + i]); S[1][4 + i] = MFMA16(fb[i], Vb[1][1], S[1][4 + i]); }
#undef LDF
#undef MM4
#pragma unroll
        for (int cg = 0; cg < 2; ++cg)
#pragma unroll
            for (int ks = 0; ks < 4; ++ks) Sb[cg][ks] = pack8(S[cg][2 * ks], S[cg][2 * ks + 1]);
        SCAN_BAR();
    }
}

typedef float f32x16 __attribute__((ext_vector_type(16)));
#define MFMA32(a, b, c) __builtin_amdgcn_mfma_f32_32x32x16_bf16((a), (b), (c), 0, 0, 0)
__device__ __forceinline__ void attn_task(int task, bf16_t* P1, int lane) {
    const int qb = task & 63, h = (task >> 6) & 7, b = task >> 9;
    const int r32 = lane & 31, hi = lane >> 5;
    const int q0 = qb * 32, qi = q0 + r32;
    bf16_t* base = P1 + (size_t)b * SEQ * N1 + 64 * h;
    bf16x8 qf[4];
#pragma unroll
    for (int c = 0; c < 4; ++c) qf[c] = *(const bf16x8*)(base + (size_t)qi * N1 + 2048 + 16 * c + 8 * hi);
    bf16x8 ua0, ua1, ones;
#pragma unroll
    for (int e = 0; e < 8; ++e) { const int key0 = 8 * (e >> 2) + 4 * hi + (e & 3); ua0[e] = (key0 > r32) ? (short)0x3F80 : (short)0; ua1[e] = (16 + key0 > r32) ? (short)0x3F80 : (short)0; ones[e] = (short)0x3F80; }
    f32x16 o[2];
#pragma unroll
    for (int i = 0; i < 16; ++i) { o[0][i] = 0.f; o[1][i] = 0.f; }
    float R = 0.f;
    const int ktd = q0 >> 6;
    bf16x8 kn[2][4];
#define LOAD_KV(KT) do { _Pragma("unroll") for (int mt = 0; mt < 2; ++mt) _Pragma("unroll") for (int c = 0; c < 4; ++c) \
        kn[mt][c] = *(const bf16x8*)(base + (size_t)((KT) * 64 + 32 * mt + r32) * N1 + 2560 + 16 * c + 8 * hi); } while (0)
    LOAD_KV(ktd);
    for (int kt = ktd; kt >= 0; --kt) {
        const int k0 = kt * 64; const bool diag = (kt == ktd);
        bf16x8 kf[2][4], vf[2][4];
#pragma unroll
        for (int mt = 0; mt < 2; ++mt)
#pragma unroll
            for (int c = 0; c < 4; ++c) { kf[mt][c] = kn[mt][c]; vf[mt][c] = *(const bf16x8*)(base + (size_t)((32 * mt + r32) * 32 + kt) * N1 + 3072 + 16 * c + 8 * hi); }
        if (kt > 0) LOAD_KV(kt - 1);
        f32x16 p[2];
#pragma unroll
        for (int i = 0; i < 16; ++i) { p[0][i] = 0.f; p[1][i] = 0.f; }
#pragma unroll
        for (int c = 0; c < 4; ++c) { p[0] = MFMA32(kf[0][c], qf[c], p[0]); p[1] = MFMA32(kf[1][c], qf[c], p[1]); }
        f32x16 lk[2]; float rs = 0.f;
#pragma unroll
        for (int mt = 0; mt < 2; ++mt)
#pragma unroll
            for (int r = 0; r < 16; ++r) { const int key = k0 + 32 * mt + (r & 3) + 8 * (r >> 2) + 4 * hi; const float z = p[mt][r];
                const float e = __builtin_amdgcn_exp2f(-fabsf(z)); const float sp = fmaxf(z, 0.f) + __builtin_amdgcn_logf(1.0f + e);
                const bool valid = !diag || key < qi; const float l = valid ? -sp : 0.f; lk[mt][r] = l; p[mt][r] = z - sp; rs += l; }
        bf16x8 lh[4];
#pragma unroll
        for (int kc = 0; kc < 4; ++kc) { u32x4 wh;
#pragma unroll
            for (int e2 = 0; e2 < 4; ++e2) wh[e2] = cvt_pk_v(lk[kc >> 1][8 * (kc & 1) + 2 * e2], lk[kc >> 1][8 * (kc & 1) + 2 * e2 + 1]);
            lh[kc] = __builtin_bit_cast(bf16x8, wh); }
        f32x16 cum[2];
#pragma unroll
        for (int i = 0; i < 16; ++i) { cum[0][i] = 0.f; cum[1][i] = 0.f; }
        cum[0] = MFMA32(ua0, lh[0], cum[0]); cum[0] = MFMA32(ua1, lh[1], cum[0]); cum[0] = MFMA32(ones, lh[2], cum[0]); cum[0] = MFMA32(ones, lh[3], cum[0]);
        cum[1] = MFMA32(ua0, lh[2], cum[1]); cum[1] = MFMA32(ua1, lh[3], cum[1]);
        bf16x8 pb[4];
#pragma unroll
        for (int kc = 0; kc < 4; ++kc) { u32x4 w; const int mt = kc >> 1;
#pragma unroll
            for (int e2 = 0; e2 < 4; ++e2) { const int ra = 8 * (kc & 1) + 2 * e2, rb = ra + 1;
                const int keya = k0 + 32 * mt + (ra & 3) + 8 * (ra >> 2) + 4 * hi, keyb = k0 + 32 * mt + (rb & 3) + 8 * (rb >> 2) + 4 * hi;
                float wa = __builtin_amdgcn_exp2f(p[mt][ra] + cum[mt][ra] + R), wb = __builtin_amdgcn_exp2f(p[mt][rb] + cum[mt][rb] + R);
                wa = (!diag || keya < qi) ? wa : 0.f; wb = (!diag || keyb < qi) ? wb : 0.f;
                w[e2] = cvt_pk_v(wa, wb); }
            pb[kc] = __builtin_bit_cast(bf16x8, w); }
#pragma unroll
        for (int kc = 0; kc < 4; ++kc) { o[0] = MFMA32(vf[0][kc], pb[kc], o[0]); o[1] = MFMA32(vf[1][kc], pb[kc], o[1]); }
        rs += __shfl_xor(rs, 32); R += rs;
        if (__ballot(R >= -150.f) == 0ull) break;
    }
#undef LOAD_KV
    bf16_t* qrow = base + (size_t)qi * N1 + 2048; const bf16_t* zrow = base + (size_t)qi * N1 + 3584;
#pragma unroll
    for (int mt = 0; mt < 2; ++mt)
#pragma unroll
        for (int g = 0; g < 4; ++g) { const int d = 32 * mt + 8 * g + 4 * hi; const u32x2 zz = *(const u32x2*)(zrow + d);
            const float v0 = o[mt][4 * g] * bflo(zz.x), v1 = o[mt][4 * g + 1] * bfhi(zz.x), v2 = o[mt][4 * g + 2] * bflo(zz.y), v3 = o[mt][4 * g + 3] * bfhi(zz.y);
            u32x2 w; w.x = cvt_pk_v(v0, v1); w.y = cvt_pk_v(v2, v3); *(u32x2*)(qrow + d) = w; }
}
__device__ __forceinline__ void attn_queue(unsigned* ctr, bf16_t* P1, int lane) {
    for (;;) { unsigned tk = 0; if (lane == 0) tk = atomicAdd(ctr, 1u); tk = (unsigned)__builtin_amdgcn_readfirstlane((int)tk); if (tk >= 16u * 8u * 64u) break; attn_task((int)tk, P1, lane); }
}

__global__ void __launch_bounds__(512, 2) fwd(Args a) {
    extern __shared__ __attribute__((aligned(16))) unsigned char lds_raw[];
    LAS unsigned char* lds = (LAS unsigned char*)lds_raw;
    cg::grid_group grid = cg::this_grid();
    const int tid = threadIdx.x, lane = tid & 63, wave = __builtin_amdgcn_readfirstlane(tid >> 6);
    const int G = gridDim.x, gw = blockIdx.x * NWAVES + wave, NGW = G * NWAVES;
    unsigned char* ws = a.ws;
    if (tid < 64) ((LAS unsigned*)(lds + 147456))[tid] = 0u;
    __syncthreads();
    XcdBarrier bar = xcd_barrier_post((unsigned*)(ws + WS_BAR), (volatile LAS unsigned*)(lds + 147456));
    bf16_t* W1T = (bf16_t*)(ws + WS_W1T); bf16_t* WGT = (bf16_t*)(ws + WS_WGT); bf16_t* WUPT = (bf16_t*)(ws + WS_WUPT); bf16_t* WOT = (bf16_t*)(ws + WS_WOT);
    float* BG = (float*)(ws + WS_BG); bf16_t* XN = (bf16_t*)(ws + WS_XN); bf16_t* P1 = (bf16_t*)(ws + WS_P1);
    bf16_t* QKVA = (bf16_t*)(ws + WS_QKVA); bf16_t* ORAW = (bf16_t*)(ws + WS_ORAW); bf16_t* MG = (bf16_t*)(ws + WS_MG);
    bf16_t* GSC = (bf16_t*)(ws + WS_GSC) + (size_t)blockIdx.x * 65536; bf16_t* GY = (bf16_t*)((unsigned char*)a.out + OUT_GY) + (size_t)blockIdx.x * 65536;

    {
        if (blockIdx.x == 0 && tid == 0) *(unsigned*)(ws + WS_CTL) = 0u;
        LAS float* scr = (LAS float*)(lds + wave * 8704);
        LAS float* W8T = (LAS float*)(lds + 69632);
        for (int i = 0; i < 16; ++i) { const int idx = tid + 512 * i, c = idx & 7, d = idx >> 3; W8T[c * 1024 + d] = a.w_in[(size_t)d * PROJ + 2048 + c]; }
        for (int it = gw; it < 4096; it += NGW) {
            int r = it;
            if (r < 2048) { const int kb = r >> 7, nb = r & 127, pn = nb >> 3, p0 = 32 * (nb & 7); const int logical = pn * 256 + 64 * ((p0 >> 5) & 3) + 32 * (p0 >> 7);
                const int src = logical < 2048 ? logical : logical + 8;
                p0_transpose_item(a.w_in, PROJ, src, 64 * kb, W1T, 32 * nb, 64 * kb, scr, lane); continue; }
            r -= 2048;
            if (r < 1024) { const int kb = r >> 6, nb = r & 63; p0_transpose_item(a.w_in, PROJ, 4104 + 32 * nb, 64 * kb, WGT, 32 * nb, 64 * kb, scr, lane); continue; }
            r -= 1024;
            if (r < 256) { const int kb = r >> 5, nb = r & 31; p0_transpose_item(a.w_up_a, DM, 32 * nb, 64 * kb, WUPT, 32 * nb, 64 * kb, scr, lane); continue; }
            r -= 256;
            if (r < 256) { const int kb = r >> 5, nb = r & 31; p0_transpose_item(a.w_up_b, DM, 32 * nb, 64 * kb, WUPT, 32 * nb, 512 + 64 * kb, scr, lane); continue; }
            r -= 256;
            { const int kb = r >> 5, nb = r & 31; p0_transpose_item(a.w_out, DM, 32 * nb, 64 * kb, WOT, 32 * nb, 64 * kb, scr, lane); }
        }
        __syncthreads();
        f32x4 gv[4];
#pragma unroll
        for (int j = 0; j < 4; ++j) gv[j] = ((const f32x4*)a.norm_gain)[lane + 64 * j];
        for (int rb = gw * 4; rb < M; rb += NGW * 4) {
            f32x4 v[4][4]; float ss[4];
#pragma unroll
            for (int q = 0; q < 4; ++q) { const f32x4* xr = (const f32x4*)(a.x + (size_t)(rb + q) * DM) + lane; ss[q] = 0.f;
#pragma unroll
                for (int j = 0; j < 4; ++j) { v[q][j] = __builtin_nontemporal_load(xr + 64 * j); } }
#pragma unroll
            for (int q = 0; q < 4; ++q)
#pragma unroll
                for (int j = 0; j < 4; ++j) ss[q] += (v[q][j][0] * v[q][j][0] + v[q][j][1] * v[q][j][1]) + (v[q][j][2] * v[q][j][2] + v[q][j][3] * v[q][j][3]);
#pragma unroll
            for (int o = 1; o < 64; o <<= 1) {
#pragma unroll
                for (int q = 0; q < 4; ++q) ss[q] += __shfl_xor(ss[q], o); }
            float bg[4][8];
#pragma unroll
            for (int q = 0; q < 4; ++q) { const float rstd = __builtin_amdgcn_rsqf(ss[q] * (1.0f / DM) + EPS);
#pragma unroll
                for (int c = 0; c < 8; ++c) bg[q][c] = 0.f;
                u32x2* o8 = (u32x2*)(XN + (size_t)(rb + q) * DM) + lane;
#pragma unroll
                for (int j = 0; j < 4; ++j) { v[q][j] = v[q][j] * rstd * gv[j]; u32x2 w; w.x = cvt_pk_bf16(v[q][j][0], v[q][j][1]); w.y = cvt_pk_bf16(v[q][j][2], v[q][j][3]); o8[64 * j] = w; } }
#pragma unroll
            for (int j = 0; j < 4; ++j)
#pragma unroll
                for (int c = 0; c < 8; ++c) { const f32x4 wv = *(const LAS f32x4*)(W8T + c * 1024 + 4 * lane + 256 * j);
#pragma unroll
                    for (int q = 0; q < 4; ++q) bg[q][c] += (v[q][j][0] * wv[0] + v[q][j][1] * wv[1]) + (v[q][j][2] * wv[2] + v[q][j][3] * wv[3]); }
#pragma unroll
            for (int q = 0; q < 4; ++q) { const bool b0 = lane & 1, b1 = lane & 2, b2 = lane & 4;
                float t4[4];
#pragma unroll
                for (int c = 0; c < 4; ++c) { const float snd = b0 ? bg[q][c] : bg[q][c + 4], keep = b0 ? bg[q][c + 4] : bg[q][c]; t4[c] = keep + __shfl_xor(snd, 1); }
                float t2[2];
#pragma unroll
                for (int c = 0; c < 2; ++c) { const float snd = b1 ? t4[c] : t4[c + 2], keep = b1 ? t4[c + 2] : t4[c]; t2[c] = keep + __shfl_xor(snd, 2); }
                float t1; { const float snd = b2 ? t2[0] : t2[1], keep = b2 ? t2[1] : t2[0]; t1 = keep + __shfl_xor(snd, 4); }
                t1 += __shfl_xor(t1, 8); t1 += __shfl_xor(t1, 16); t1 += __shfl_xor(t1, 32);
                if (lane < 8) BG[(size_t)(rb + q) * 8 + (b0 ? 4 : 0) + (b1 ? 2 : 0) + (b2 ? 1 : 0)] = t1; }
        }
    }
    if (a.never) grid.sync();
    xcd_barrier(bar);

    {
        pg8::SchedPlain S{(const char*)XN, (const char*)W1T, 16, 128, 16, G, (int)blockIdx.x};
        pg8::Epi1 E{P1, a.sb_q_gain, a.sb_k_gain};
        pg8::gemm_phase<pg8::Epi1, pg8::SchedPlain>(lds, S, E);
    }
    xcd_barrier(bar);

    {
        for (int run = gw; run < M / 16; run += NGW) {
            const int t0 = run * 16; const bool seq_start = (t0 % SEQ) == 0;
#pragma unroll
            for (int g = 0; g < 3; ++g) {
                float cw[4][8];
#pragma unroll
                for (int tp = 0; tp < 4; ++tp) { const f32x4 c0 = *(const f32x4*)(a.conv_w + tp * 1536 + 512 * g + 8 * lane), c1 = *(const f32x4*)(a.conv_w + tp * 1536 + 512 * g + 8 * lane + 4);
#pragma unroll
                    for (int e = 0; e < 4; ++e) { cw[tp][e] = c0[e]; cw[tp][4 + e] = c1[e]; } }
                u32x4 rows[19];
#pragma unroll
                for (int k = 0; k < 19; ++k) rows[k] = (k < 3 && seq_start) ? (u32x4){0u, 0u, 0u, 0u} : __builtin_nontemporal_load((const u32x4*)(P1 + (size_t)(t0 - 3 + k) * N1 + 512 * g + 8 * lane));
#pragma unroll
                for (int tt = 0; tt < 16; ++tt) {
                    float val[8]; float ss = 0.f;
#pragma unroll
                    for (int e2 = 0; e2 < 4; ++e2) {
                        const unsigned w0 = rows[tt][e2], w1 = rows[tt + 1][e2], w2 = rows[tt + 2][e2], w3 = rows[tt + 3][e2];
                        float lo = cw[0][2 * e2] * bflo(w0) + cw[1][2 * e2] * bflo(w1) + cw[2][2 * e2] * bflo(w2) + cw[3][2 * e2] * bflo(w3);
                        float hi = cw[0][2 * e2 + 1] * bfhi(w0) + cw[1][2 * e2 + 1] * bfhi(w1) + cw[2][2 * e2 + 1] * bfhi(w2) + cw[3][2 * e2 + 1] * bfhi(w3);
                        lo = lo * sigmoidf_(lo); hi = hi * sigmoidf_(hi);
                        val[2 * e2] = lo; val[2 * e2 + 1] = hi; ss += lo * lo + hi * hi;
                    }
                    float sc = 1.f;
                    if (g < 2) { ss = red16(ss); sc = __builtin_amdgcn_rsqf(ss + EPS); if (g == 0) sc *= 0.08838834764831845f; }
                    u32x4 w; w.x = cvt_pk_bf16(val[0] * sc, val[1] * sc); w.y = cvt_pk_bf16(val[2] * sc, val[3] * sc); w.z = cvt_pk_bf16(val[4] * sc, val[5] * sc); w.w = cvt_pk_bf16(val[6] * sc, val[7] * sc);
                    *(u32x4*)(QKVA + (size_t)(t0 + tt) * 1536 + 512 * g + 8 * lane) = w;
                }
            }
            { const int tk = lane >> 2, hh = lane & 3; float* bgp = BG + (size_t)(t0 + tk) * 8; const float blv = bgp[hh], dlv = bgp[4 + hh];
              const float beta = sigmoidf_(blv); const float xx = dlv + a.dt_bias[hh]; const float sp = fmaxf(xx, 0.f) + log1pf(expf(-fabsf(xx)));
              const float gg = -expf(a.a_log[hh]) * sp; bgp[hh] = beta; bgp[4 + hh] = gg; }
        }
    }
    unsigned* actr = (unsigned*)(ws + WS_CTL);
    unsigned char* REC = (unsigned char*)a.out + OUT_REC; bf16_t* UF = (bf16_t*)(ws + WS_UF); float* GE = (float*)(ws + WS_GE);
    if (G == 256) { asm volatile("s_waitcnt vmcnt(0)" ::: "memory"); __syncthreads();
        const int bb = blockIdx.x >> 4, n0 = 2 * (blockIdx.x & 15); dn_prep((bb * 4 + (wave & 3)) * 32 + n0 + (wave >> 2), lds + wave * 18432, QKVA, BG, REC, UF, GE, lane); }
    else { xcd_barrier(bar); for (int task = blockIdx.x * 8 + wave; task < 2048; task += G * 8) dn_prep(task, lds + wave * 18432, QKVA, BG, REC, UF, GE, lane); }
    xcd_barrier(bar);

    if (G == 256) { if (((blockIdx.x >> 3) & 3) == 0) dn_scan_wg((blockIdx.x >> 5) * 8 + (blockIdx.x & 7), lds, REC, UF, GE, ORAW, tid, wave, lane); }
    else { for (int bh = blockIdx.x; bh < 64; bh += G) dn_scan_wg(bh, lds, REC, UF, GE, ORAW, tid, wave, lane); }
    attn_queue(actr, P1, lane);
    xcd_barrier(bar);

    {
        int lane4 = lane; asm volatile("" : "+v"(lane4));
        f32x4 g0 = *(const f32x4*)(a.dn_out_gain + ((8 * lane4) & 127)), g1 = *(const f32x4*)(a.dn_out_gain + ((8 * lane4) & 127) + 4);
        for (int rb = gw * 4; rb < M; rb += NGW * 4) {
            u32x4 ov4[4], zv4[4];
#pragma unroll
            for (int q = 0; q < 4; ++q) { ov4[q] = __builtin_nontemporal_load((const u32x4*)(ORAW + (size_t)(rb + q) * 512 + 8 * lane)); zv4[q] = __builtin_nontemporal_load((const u32x4*)(P1 + (size_t)(rb + q) * N1 + 1536 + 8 * lane)); }
#pragma unroll
            for (int q = 0; q < 4; ++q) { const u32x4 ov = ov4[q], zv = zv4[q];
                float v[8] = {bflo(ov.x), bfhi(ov.x), bflo(ov.y), bfhi(ov.y), bflo(ov.z), bfhi(ov.z), bflo(ov.w), bfhi(ov.w)};
                const float z[8] = {bflo(zv.x), bfhi(zv.x), bflo(zv.y), bfhi(zv.y), bflo(zv.z), bfhi(zv.z), bflo(zv.w), bfhi(zv.w)};
                float ss = 0.f;
#pragma unroll
                for (int i = 0; i < 8; ++i) ss += v[i] * v[i];
                ss = red16(ss);
                const float rs = __builtin_amdgcn_rsqf(ss * (1.0f / 128.0f) + EPS);
#pragma unroll
                for (int i = 0; i < 8; ++i) v[i] = v[i] * rs * (i < 4 ? g0[i & 3] : g1[i & 3]) * z[i];
                u32x4 w; w.x = cvt_pk_bf16(v[0], v[1]); w.y = cvt_pk_bf16(v[2], v[3]); w.z = cvt_pk_bf16(v[4], v[5]); w.w = cvt_pk_bf16(v[6], v[7]);
                *(u32x4*)(P1 + (size_t)(rb + q) * N1 + 1536 + 8 * lane) = w; }
        }
    }
    xcd_barrier(bar);

    {
        pg8::SchedP5 S{(const char*)XN, (const char*)WGT, (const char*)P1, (const char*)WUPT, G, (int)blockIdx.x};
        pg8::Epi5 E{a.b_gate, GSC, GY, MG};
        pg8::gemm_phase<pg8::Epi5, pg8::SchedP5>(lds, S, E);
    }
    xcd_barrier(bar);

    {
        pg8::SchedPlain S{(const char*)MG, (const char*)WOT, 16, 128, 4, G, (int)blockIdx.x};
        pg8::Epi6 E{a.x, a.out};
        pg8::gemm_phase<pg8::Epi6, pg8::SchedPlain>(lds, S, E);
    }
}

extern "C" void kernel_launch(void* const* d_in, const int* in_sizes, int n_in, void* d_out, int out_size, void* d_ws, size_t ws_size, hipStream_t stream) {
    static int grid = 0;
    if (grid == 0) {
        if (n_in != 13 || out_size != M * DM || ws_size < WS_END) { fprintf(stderr, "kernel_launch: unexpected problem (n_in %d out %d ws %zu)\n", n_in, out_size, ws_size); grid = -1; return; }
        int dev = 0, cus = 0, per_cu = 0;
        (void)hipGetDevice(&dev); (void)hipDeviceGetAttribute(&cus, hipDeviceAttributeMultiprocessorCount, dev);
        (void)hipFuncSetAttribute((const void*)fwd, hipFuncAttributeMaxDynamicSharedMemorySize, LDS_BYTES);
        (void)hipOccupancyMaxActiveBlocksPerMultiprocessor(&per_cu, (const void*)fwd, NWAVES * 64, LDS_BYTES);
        if (per_cu < 1) fprintf(stderr, "kernel_launch: occupancy query says %d blocks per CU\n", per_cu);
        grid = cus;
    }
    if (grid < 0) return;
    (void)hipMemsetAsync((unsigned char*)d_ws + WS_BAR, 0, XCD_BAR_WORDS * 4, stream);
    Args a{};
    a.x = (const float*)d_in[0]; a.norm_gain = (const float*)d_in[1]; a.w_in = (const float*)d_in[2]; a.b_gate = (const float*)d_in[3]; a.conv_w = (const float*)d_in[4];
    a.a_log = (const float*)d_in[5]; a.dt_bias = (const float*)d_in[6]; a.dn_out_gain = (const float*)d_in[7]; a.sb_q_gain = (const float*)d_in[8]; a.sb_k_gain = (const float*)d_in[9];
    a.w_up_a = (const float*)d_in[10]; a.w_up_b = (const float*)d_in[11]; a.w_out = (const float*)d_in[12];
    a.out = (float*)d_out; a.ws = (unsigned char*)d_ws;
    void* args[] = {&a};
    hipError_t e = hipLaunchCooperativeKernel((const void*)fwd, dim3(grid), dim3(NWAVES * 64), args, LDS_BYTES, stream);
    if (e != hipSuccess) fprintf(stderr, "kernel_launch: cooperative launch failed: %s (grid %d)\n", hipGetErrorString(e), grid);
}
```
